# Optimizing an MI355X kernel written in HIP

```python
import jax, jax.numpy as jnp
from jax import lax
import numpy as np

D_MODEL = 2048
BATCH = 2
SEQ = 4096
DEPTH = 2

HEAD_DIM = 128
DIL_PATTERNS = ((128, 1), (512, 4), (2048, 16))
A_HEADS_PER_GROUP = 4
A_GROUPS = len(DIL_PATTERNS)
A_HEADS = A_HEADS_PER_GROUP * A_GROUPS
A_WIDTH = A_HEADS * HEAD_DIM
A_OUT = A_HEADS_PER_GROUP * HEAD_DIM
ATT_BLOCK = 128
ROT_DIM = HEAD_DIM // 4
ROPE_THETA = 500000.0
GLA_HEADS = 4
GLA_DK = D_MODEL // 2
GLA_DV = D_MODEL
GLA_HK = GLA_DK // GLA_HEADS
GLA_HV = GLA_DV // GLA_HEADS
GLA_LOWRANK = 16
GLA_TAU = 16.0
GLA_CHUNK = 64
IN_SIZES = (A_WIDTH, A_WIDTH, A_WIDTH, GLA_DK, GLA_DK, GLA_DV, GLA_DV, GLA_LOWRANK, D_MODEL, D_MODEL)
N_IN = sum(IN_SIZES)
N_EXPERTS = 16
N_GROUPS = 4
EXPERTS_PER_GROUP = N_EXPERTS // N_GROUPS
TOP_K = 2
D_FF_EXPERT = 1408
DN_ALPHA = (2 * DEPTH) ** 0.25
DN_BETA = (8 * DEPTH) ** -0.25
LN_EPS = 1e-5
RMS_EPS = 1e-6

kernel_name = "hybrid_dilated_gla_groupmoe_deepnorm"


def layer_norm(x, g, b):
    xf = x.astype(jnp.float32)
    mu = jnp.mean(xf, axis=-1, keepdims=True)
    var = jnp.mean(jnp.square(xf - mu), axis=-1, keepdims=True)
    return ((xf - mu) * lax.rsqrt(var + LN_EPS) * g.astype(jnp.float32) + b.astype(jnp.float32)).astype(x.dtype)


def rope_tables(positions):
    inv = ROPE_THETA ** (-jnp.arange(0, ROT_DIM, 2, dtype=jnp.float32) / ROT_DIM)
    ang = positions.astype(jnp.float32)[..., None] * inv
    return jnp.cos(ang)[:, :, None, :], jnp.sin(ang)[:, :, None, :]


def apply_partial_rope(x, cos, sin):
    xr = x[..., :ROT_DIM].astype(jnp.float32)
    x1, x2 = xr[..., :ROT_DIM // 2], xr[..., ROT_DIM // 2:]
    rot = jnp.concatenate([x1 * cos - x2 * sin, x2 * cos + x1 * sin], axis=-1).astype(x.dtype)
    return jnp.concatenate([rot, x[..., ROT_DIM:]], axis=-1)


def dilated_group_attention(q, k, v, window, dil):
    B_, S_, H_, Dh = q.shape
    n_off = window // dil
    L = S_ // dil
    nb = -(-L // ATT_BLOCK)
    Lp = nb * ATT_BLOCK

    def to_sub(t):
        t = t.reshape(B_, L, dil, H_, Dh).transpose(0, 2, 1, 3, 4).reshape(B_ * dil, L, H_, Dh)
        t = jnp.pad(t, ((0, 0), (0, Lp - L), (0, 0), (0, 0)))
        return t.reshape(B_ * dil, nb, ATT_BLOCK, H_, Dh)

    qb, kb, vb = to_sub(q), to_sub(k), to_sub(v)

    def with_prev(t):
        prev = jnp.concatenate([jnp.zeros_like(t[:, :1]), t[:, :-1]], axis=1)
        return jnp.concatenate([prev, t], axis=2)

    kk, vv = with_prev(kb), with_prev(vb)
    s = jnp.einsum('nbqhd,nbkhd->nbhqk', qb, kk).astype(jnp.float32) * (Dh ** -0.5)
    qi = jnp.arange(nb)[:, None] * ATT_BLOCK + jnp.arange(ATT_BLOCK)[None, :]
    kj = jnp.arange(nb)[:, None] * ATT_BLOCK - ATT_BLOCK + jnp.arange(2 * ATT_BLOCK)[None, :]
    rel = qi[:, :, None] - kj[:, None, :]
    mask = (kj[:, None, :] >= 0) & (rel >= 0) & (rel <= n_off)
    s = jnp.where(mask[None, :, None], s, -jnp.inf)
    m = jnp.max(s, axis=-1, keepdims=True)
    p = jnp.exp(s - m)
    den = jnp.sum(p, axis=-1, keepdims=True)
    o = jnp.einsum('nbhqk,nbkhd->nbqhd', (p / den).astype(v.dtype), vv)
    lse = (m + jnp.log(den))[..., 0]
    o = o.reshape(B_, dil, Lp, H_, Dh)[:, :, :L].transpose(0, 2, 1, 3, 4).reshape(B_, S_, H_, Dh)
    lse = lse.transpose(0, 1, 3, 2).reshape(B_, dil, Lp, H_)[:, :, :L].transpose(0, 2, 1, 3).reshape(B_, S_, H_)
    return o, lse


def gla_chunked(q, k, v, log_a):
    B_, S_, H_, DK = q.shape
    DV = v.shape[-1]
    C = GLA_CHUNK
    n = S_ // C
    qc = q.astype(jnp.float32).reshape(B_, n, C, H_, DK) * (DK ** -0.5)
    kc = k.astype(jnp.float32).reshape(B_, n, C, H_, DK)
    vc = v.astype(jnp.float32).reshape(B_, n, C, H_, DV)
    b = jnp.cumsum(log_a.reshape(B_, n, C, H_, DK), axis=2)
    b_last = b[:, :, -1:]
    q_t = qc * jnp.exp(b)
    k_t = kc * jnp.exp(-b)
    k_dec = kc * jnp.exp(b_last - b)
    causal = jnp.tril(jnp.ones((C, C), dtype=bool))
    att = jnp.where(causal, jnp.einsum('bnchk,bnshk->bnhcs', q_t, k_t), 0.0)
    o_intra = jnp.einsum('bnhcs,bnshv->bnchv', att, vc)
    decay = jnp.exp(b_last[:, :, 0])

    def step(state, inp):
        q_i, kd_i, v_i, dec_i = inp
        o_i = jnp.einsum('bchk,bhkv->bchv', q_i, state)
        state = state * dec_i[..., None] + jnp.einsum('bchk,bchv->bhkv', kd_i, v_i)
        return state, o_i

    init = jnp.zeros((B_, H_, DK, DV), jnp.float32)
    _, o_inter = lax.scan(step, init, (jnp.moveaxis(q_t, 1, 0), jnp.moveaxis(k_dec, 1, 0),
                                       jnp.moveaxis(vc, 1, 0), jnp.moveaxis(decay, 1, 0)))
    o = o_intra + jnp.moveaxis(o_inter, 0, 1)
    return o.reshape(B_, S_, H_, DV)


def hybrid_mixer(h, cos, sin, w_in, w_gk2, b_gk, g_gla, p_a, p_b, w_o):
    B_, S_, _ = h.shape
    proj = h @ w_in
    splits = [int(c) for c in np.cumsum(IN_SIZES)[:-1]]
    qa, ka, va, qb, kb, vb, rb, gk_low, ga, gb = jnp.split(proj, splits, axis=-1)

    qa = apply_partial_rope(qa.reshape(B_, S_, A_HEADS, HEAD_DIM), cos, sin)
    ka = apply_partial_rope(ka.reshape(B_, S_, A_HEADS, HEAD_DIM), cos, sin)
    va = va.reshape(B_, S_, A_HEADS, HEAD_DIM)
    outs, lses = [], []
    for g, (window, dil) in enumerate(DIL_PATTERNS):
        hs = slice(g * A_HEADS_PER_GROUP, (g + 1) * A_HEADS_PER_GROUP)
        o_g, lse_g = dilated_group_attention(qa[:, :, hs], ka[:, :, hs], va[:, :, hs], window, dil)
        outs.append(o_g)
        lses.append(lse_g)
    wts = jax.nn.softmax(jnp.stack(lses, axis=0), axis=0)
    y_a = jnp.sum(wts[..., None] * jnp.stack(outs, axis=0).astype(jnp.float32), axis=0)
    y_a = y_a.astype(h.dtype).reshape(B_, S_, A_OUT)

    gk = (gk_low @ w_gk2 + b_gk).astype(jnp.float32)
    log_a = (jax.nn.log_sigmoid(gk) / GLA_TAU).reshape(B_, S_, GLA_HEADS, GLA_HK)
    o_b = gla_chunked(qb.reshape(B_, S_, GLA_HEADS, GLA_HK), kb.reshape(B_, S_, GLA_HEADS, GLA_HK),
                      vb.reshape(B_, S_, GLA_HEADS, GLA_HV), log_a)
    o_b = o_b * lax.rsqrt(jnp.mean(jnp.square(o_b), axis=-1, keepdims=True) + RMS_EPS) * g_gla.astype(jnp.float32)
    y_b = (o_b.reshape(B_, S_, GLA_DV) * jax.nn.silu(rb.astype(jnp.float32))).astype(h.dtype)

    gate_a = jax.nn.sigmoid(ga.astype(jnp.float32)).astype(h.dtype)
    gate_b = jax.nn.sigmoid(gb.astype(jnp.float32)).astype(h.dtype)
    merged = gate_a * (y_a @ p_a) + gate_b * (y_b @ p_b)
    return merged @ w_o


def group_moe(h, router_w, router_b, w_gate, w_up, w_down):
    shape = h.shape
    t = h.reshape(-1, shape[-1])
    logits = (t @ router_w).astype(jnp.float32) + router_b.astype(jnp.float32)
    probs = jax.nn.softmax(logits, axis=-1)
    grouped = probs.reshape(-1, N_GROUPS, EXPERTS_PER_GROUP)
    group_score = jnp.sum(lax.top_k(grouped, TOP_K)[0], axis=-1)
    g_sel = jnp.argmax(group_score, axis=-1)
    in_group = (jnp.arange(N_EXPERTS) // EXPERTS_PER_GROUP)[None, :] == g_sel[:, None]
    top_v, top_i = lax.top_k(jnp.where(in_group, probs, -1.0), TOP_K)
    top_w = top_v / jnp.sum(top_v, axis=-1, keepdims=True)
    combine = jnp.sum(jax.nn.one_hot(top_i, N_EXPERTS, dtype=jnp.float32) * top_w[..., None], axis=1)
    combine = combine.astype(t.dtype)
    y = jnp.zeros_like(t)
    for e in range(N_EXPERTS):
        a = t @ w_gate[e]
        u = t @ w_up[e]
        y = y + combine[:, e:e + 1] * ((jax.nn.silu(a) * u) @ w_down[e])
    return y.reshape(shape)


def setup_inputs(seed: int = 0) -> dict:
    key = jax.random.key(seed)
    ks = jax.random.split(key, 20)
    f32 = jnp.float32
    x = jax.random.normal(ks[0], (BATCH, SEQ, D_MODEL), f32)
    offset = jax.random.randint(ks[1], (BATCH, 1), 0, 1024, dtype=jnp.int32)
    positions = (offset + jnp.arange(SEQ, dtype=jnp.int32)[None, :]).astype(jnp.int32)
    col_scale = np.concatenate([np.full(s, c, np.float32) for s, c in zip(
        IN_SIZES, (1.0, 1.0, DN_BETA, 1.0, 1.0, DN_BETA, 1.0, 1.0, 1.0, 1.0))])
    w_in = jax.random.normal(ks[2], (DEPTH, D_MODEL, N_IN), f32) * (D_MODEL ** -0.5) * jnp.asarray(col_scale)
    w_gk2 = jax.random.normal(ks[3], (DEPTH, GLA_LOWRANK, GLA_DK), f32) * (GLA_LOWRANK ** -0.5)
    b_gk = jax.random.normal(ks[4], (DEPTH, GLA_DK), f32) * 0.1
    g_gla = 1.0 + 0.02 * jax.random.normal(ks[5], (DEPTH, GLA_HV), f32)
    p_a = jax.random.normal(ks[6], (DEPTH, A_OUT, D_MODEL), f32) * (A_OUT ** -0.5)
    p_b = jax.random.normal(ks[7], (DEPTH, GLA_DV, D_MODEL), f32) * (GLA_DV ** -0.5)
    w_o = jax.random.normal(ks[8], (DEPTH, D_MODEL, D_MODEL), f32) * (D_MODEL ** -0.5) * DN_BETA
    ln1_g = 1.0 + 0.02 * jax.random.normal(ks[9], (DEPTH, D_MODEL), f32)
    ln1_b = 0.02 * jax.random.normal(ks[10], (DEPTH, D_MODEL), f32)
    router_w = jax.random.normal(ks[11], (D_MODEL, N_EXPERTS), f32) * (D_MODEL ** -0.5)
    router_b = 0.01 * jax.random.normal(ks[12], (N_EXPERTS,), f32)
    w_gate = jax.random.normal(ks[13], (DEPTH, N_EXPERTS, D_MODEL, D_FF_EXPERT), f32) * (D_MODEL ** -0.5)
    w_up = jax.random.normal(ks[14], (DEPTH, N_EXPERTS, D_MODEL, D_FF_EXPERT), f32) * (D_MODEL ** -0.5)
    w_down = jax.random.normal(ks[15], (DEPTH, N_EXPERTS, D_FF_EXPERT, D_MODEL), f32) * (D_FF_EXPERT ** -0.5) * DN_BETA
    ln2_g = 1.0 + 0.02 * jax.random.normal(ks[16], (DEPTH, D_MODEL), f32)
    ln2_b = 0.02 * jax.random.normal(ks[17], (DEPTH, D_MODEL), f32)
    return {"x": x, "positions": positions, "w_in": w_in, "w_gk2": w_gk2, "b_gk": b_gk, "g_gla": g_gla,
            "p_a": p_a, "p_b": p_b, "w_o": w_o, "ln1_g": ln1_g, "ln1_b": ln1_b,
            "router_w": router_w, "router_b": router_b, "w_gate": w_gate, "w_up": w_up,
            "w_down": w_down, "ln2_g": ln2_g, "ln2_b": ln2_b}


def reference(x, positions, w_in, w_gk2, b_gk, g_gla, p_a, p_b, w_o, ln1_g, ln1_b,
              router_w, router_b, w_gate, w_up, w_down, ln2_g, ln2_b):
    cos, sin = rope_tables(positions)
    h = x
    for l in range(DEPTH):
        mix = hybrid_mixer(h, cos, sin, w_in[l], w_gk2[l], b_gk[l], g_gla[l], p_a[l], p_b[l], w_o[l])
        h = layer_norm(DN_ALPHA * h + mix, ln1_g[l], ln1_b[l])
        ffn = group_moe(h, router_w, router_b, w_gate[l], w_up[l], w_down[l])
        h = layer_norm(DN_ALPHA * h + ffn, ln2_g[l], ln2_b[l])
    return h
```

```cpp
#include <hip/hip_runtime.h>
#include <stdint.h>
#include <stdio.h>
#include <math.h>

typedef unsigned short u16;
constexpr int T = 8192, SEQ = 4096, D = 2048, NIN = 14864, DEPTH = 2;
constexpr int NE = 16, DFF = 1408;
constexpr size_t MiB = 1u << 20;
constexpr float DN_ALPHA = 1.41421356237309515f;
constexpr int C_QA = 0, C_KA = 1536, C_VA = 3072, C_QB = 4608, C_KB = 5632, C_VB = 6656, C_RB = 8704, C_GK = 10752, C_GA = 10768, C_GB = 12816;

__device__ __forceinline__ u16 f2bf(float f) { unsigned u = __float_as_uint(f); u += 0x7fffu + ((u >> 16) & 1u); return (u16)(u >> 16); }
__device__ __forceinline__ float bf2f(u16 b) { return __uint_as_float(((unsigned)b) << 16); }
__device__ __forceinline__ float wave_sum(float v) {
#pragma unroll
    for (int o = 1; o < 64; o <<= 1) v += __shfl_xor(v, o);
    return v;
}
__device__ __forceinline__ float wave_max(float v) {
#pragma unroll
    for (int o = 1; o < 64; o <<= 1) v = fmaxf(v, __shfl_xor(v, o));
    return v;
}

#define LAS __attribute__((address_space(3)))
#ifndef ATTN_SIMPLE
#define ATTN_SIMPLE 0
#endif
#ifndef GLA_SIMPLE
#define GLA_SIMPLE 0
#endif
#ifndef ONE_LAUNCH
#define ONE_LAUNCH 1
#endif
#ifndef BG_WGS
#define BG_WGS 64
#endif
constexpr int NP_WIN = 16 * ((NIN + 63) / 64), NP_LAYER = NP_WIN + 128 + 512 + 512 + 3 * 5632, NP_ALL = 2 * NP_LAYER;
constexpr int BGP_A = BG_WGS ? NP_WIN : NP_ALL;
#ifndef BG_PA
#define BG_PA 25
#endif
#ifndef BG_PB
#define BG_PB 14
#endif
constexpr int BGP_B = BG_WGS ? BGP_A + BG_WGS * 8 * BG_PA : NP_ALL;
constexpr int BGP_C = BG_WGS ? BGP_B + BG_WGS * 8 * BG_PB : NP_ALL;
constexpr int BGP_D = BG_WGS ? NP_LAYER + NP_WIN : NP_ALL;
constexpr int BGP_E = BG_WGS ? BGP_D + BG_WGS * 8 * BG_PA : NP_ALL;
constexpr int BGP_F = NP_ALL;
#ifndef BG_GU1
#define BG_GU1 48
#endif
static_assert(BG_WGS == 0 || (BGP_B >= NP_WIN + 128 + 512 + 512 + 2 * 5632 && BGP_C >= NP_LAYER && BGP_C <= BGP_D && BGP_E >= NP_LAYER + NP_WIN + 128 + 512 + 512 + 2 * 5632 && BGP_E <= NP_ALL), "background conversion ranges vs first use");
#ifndef WT_STORES
#define WT_STORES 0
#endif
#ifndef BAUX_MOE
#define BAUX_MOE 0
#endif
#ifndef HALF_UNITS
#define HALF_UNITS 1
#endif
#ifndef MOE_CHAIN
#define MOE_CHAIN 0
#endif
#ifndef DN_F8
#define DN_F8 1
#endif
#ifndef SN_F8
#define SN_F8 1
#endif
#ifndef USE_F8
#define USE_F8 15
#endif
constexpr bool F8_IN = (USE_F8 & 1) != 0, F8_MOE = (USE_F8 & 2) != 0, F8_WO = (USE_F8 & 4) != 0, F8_MRG = (USE_F8 & 8) != 0;
typedef short bf16x8 __attribute__((ext_vector_type(8)));
typedef float f32x4 __attribute__((ext_vector_type(4)));
typedef unsigned u32x4 __attribute__((ext_vector_type(4)));
typedef unsigned u32x2 __attribute__((ext_vector_type(2)));
typedef int i32x4 __attribute__((ext_vector_type(4)));
typedef int i32x8 __attribute__((ext_vector_type(8)));
typedef float f32x2_t __attribute__((ext_vector_type(2)));
typedef __bf16 bf16x2_t __attribute__((ext_vector_type(2)));
__device__ __forceinline__ unsigned cvtpk(float lo, float hi) { f32x2_t v = {lo, hi}; bf16x2_t b = __builtin_convertvector(v, bf16x2_t); return __builtin_bit_cast(unsigned, b); }
__device__ __forceinline__ float bflo(unsigned w) { return __uint_as_float(w << 16); }
__device__ __forceinline__ float bfhi(unsigned w) { return __uint_as_float(w & 0xffff0000u); }
typedef float f32x2v __attribute__((ext_vector_type(2)));
__device__ __forceinline__ bf16x8 ld_f8x8(const unsigned char* p) {
    const u32x2 q = *(const u32x2*)p; const f32x2v a = __builtin_amdgcn_cvt_pk_f32_fp8((int)q.x, false), b = __builtin_amdgcn_cvt_pk_f32_fp8((int)q.x, true), c = __builtin_amdgcn_cvt_pk_f32_fp8((int)q.y, false), d = __builtin_amdgcn_cvt_pk_f32_fp8((int)q.y, true);
    u32x4 w; w.x = cvtpk(a[0], a[1]); w.y = cvtpk(b[0], b[1]); w.z = cvtpk(c[0], c[1]); w.w = cvtpk(d[0], d[1]); return __builtin_bit_cast(bf16x8, w); }
constexpr float F8_ACT = 8.f, F8_WGT = 64.f, F8_INV = 1.f / (F8_ACT * F8_WGT);
__device__ __forceinline__ unsigned cvt4_f8(float a, float b, float c, float d) {
    a = fminf(fmaxf(a, -448.f), 448.f); b = fminf(fmaxf(b, -448.f), 448.f); c = fminf(fmaxf(c, -448.f), 448.f); d = fminf(fmaxf(d, -448.f), 448.f);
    int r = __builtin_amdgcn_cvt_pk_fp8_f32(a, b, 0, false); r = __builtin_amdgcn_cvt_pk_fp8_f32(c, d, r, true); return (unsigned)r; }
__device__ __forceinline__ int lane_id() { int l; asm volatile("v_mbcnt_lo_u32_b32 %0, -1, 0\n\tv_mbcnt_hi_u32_b32 %0, -1, %0" : "=v"(l)); return l; }
#define WV_TID(wv_) ((wv_) * 64 + lane_id())
__device__ __forceinline__ float fsigmoid(float x) { return __builtin_amdgcn_rcpf(1.f + __expf(-x)); }

constexpr size_t WS_CTL = 0, CTL_ZERO_BYTES = 131072;
constexpr size_t WS_TAB = 1 * MiB;
constexpr int NWIN = 15104;
constexpr size_t WS_WIN = 2 * MiB, SZ_WIN = (size_t)NWIN * D * 2;
constexpr int KAB = 2560;
constexpr size_t WS_PAB = WS_WIN + 2 * SZ_WIN, SZ_PAB = (size_t)D * KAB * 2;
constexpr size_t WS_WO = WS_PAB + 2 * SZ_PAB, SZ_WO = (size_t)D * D * 2;
constexpr size_t WS_WGU = WS_WO + 2 * SZ_WO, SZ_WGU = (size_t)NE * 2816 * D * 2;
constexpr size_t WS_WD = WS_WGU + 2 * SZ_WGU, SZ_WD = (size_t)NE * D * DFF * 2;
constexpr size_t WS_WEND = WS_WD + 2 * SZ_WD;
static_assert(WS_WEND <= 684 * MiB, "weights");

constexpr size_t P_HC = 684 * MiB, P_HB = 748 * MiB;
constexpr size_t P_QA = 780 * MiB, P_KA = 804 * MiB, P_VA = 828 * MiB, P_QB = 852 * MiB, P_KB = 868 * MiB, P_VB = 884 * MiB, P_RB = 916 * MiB, P_GA = 948 * MiB, P_GB = 980 * MiB;
constexpr size_t P_GKL = 1012 * MiB, P_OA = 1013 * MiB, P_LSE = 1037 * MiB, P_YAB = 1038 * MiB;
constexpr size_t P_QT = 1078 * MiB, P_KDT = 1094 * MiB, P_ATT = 1110 * MiB, P_DEC = 1114 * MiB, P_SN = 1115 * MiB;
constexpr size_t P_OB = 1115 * MiB;
constexpr size_t P_MRG = 780 * MiB, P_PRE1 = 884 * MiB, P_H1 = 948 * MiB, P_H1B = 1046 * MiB, P_XG = 1078 * MiB, P_ACT = 1158 * MiB, P_DN = 812 * MiB;
static_assert(P_VA - P_KA == P_KA - P_QA && P_GA - P_RB == P_RB - P_VB && P_GB - P_GA == P_RB - P_VB, "in-projection output groups must be equally spaced");
constexpr size_t P_TOK = 1243 * MiB, P_TI = 1244 * MiB, P_VT = 1245 * MiB, P_END = 1277 * MiB;
constexpr int MAXROWS = 20480;

constexpr int LDS_BYTES = 155648;
constexpr int MISC_OFF = 147456;

namespace pg8 {
constexpr int BM = 256, BK = 64, HALF = 128, HTB = HALF * BK * 2, STAGE_BYTES = 8 * HTB, NXCD = 8, WGM = 8;
__host__ __device__ __forceinline__ int lds_byte(int r, int c) { const int st = (r >> 4) * 2 + (c >> 5), rr = r & 15, cc = c & 31, ob = rr * 64 + cc * 2; return st * 1024 + (ob ^ (((ob >> 9) & 1) << 5)); }
__host__ __device__ __forceinline__ void stage_rc(int b, int& R, int& C) { const int st = b / 1024, sb = b % 1024, swz = sb ^ (((sb >> 9) & 1) << 5); R = (st >> 1) * 16 + swz / 64; C = (st & 1) * 32 + (swz % 64) / 2; }
__host__ __device__ __forceinline__ int perm32(int rho) { const int n = rho >> 4, i = rho & 15; return 8 * (i >> 2) + 4 * n + (i & 3); }
__device__ __forceinline__ int xcd_remap(int L, int nwg) { const int q = nwg / NXCD, r = nwg % NXCD, xcd = L % NXCD, off = L / NXCD; return (xcd < r ? xcd * (q + 1) : r * (q + 1) + (xcd - r) * q) + off; }
__device__ __forceinline__ bool deal(int i, int c, int G, int nwg, bool halves, int& L, int& hm) {
    const int nfull = nwg / G, R = nwg - nfull * G; hm = 0;
    if (i < nfull) { L = i * G + c; return true; }
    if (i > nfull || R == 0) return false;
    if (halves && 2 * R <= G) { if (c >= 2 * R) return false; L = nfull * G + (c >> 1); hm = 1 + (c & 1); return true; }
    if (c >= R) return false; L = nfull * G + c; return true; }
__device__ __forceinline__ void tile_of(int wgid, int nM, int nN, int& pm, int& pn) { const int nig = WGM * nN, gid = wgid / nig, fm = gid * WGM, gsz = (nM - fm) < WGM ? (nM - fm) : WGM; pm = fm + ((wgid % nig) % gsz); pn = (wgid % nig) / gsz; }

struct GUnit { const char* A; const char* B; unsigned lda2, ldb2; int nt, pm, pn, aux, hm; };

template <class P>
__device__ __forceinline__ void gemm_run(LAS unsigned char* lds, const P& S, int wv) {
    int tid = WV_TID(wv); asm volatile("" : "+v"(tid));
    const int wid = __builtin_amdgcn_readfirstlane(tid >> 6), lane = tid & 63, wr = wid >> 2, wc = wid & 3, fr = lane & 15, fq = lane >> 4;
    int sRA[2], sRB[2], sC[2];
#pragma unroll
    for (int i = 0; i < 2; ++i) { int R, C; stage_rc(tid * 16 + i * 8192, R, C); sRA[i] = R; sRB[i] = P::PERM ? ((R & ~31) + perm32(R & 31)) : R; sC[i] = C * 2; }
    const size_t kstep = (size_t)(BK * 2);
    const unsigned ldsw = (unsigned)wid * 1024u;
    const int aoff = lds_byte(wr * 64 + fr, fq * 8), boff = lds_byte(wc * 32 + fr, fq * 8);
#define PG8_SA(b, h) (((b) * 2 + (h)) * HTB)
#define PG8_SB(b, h) ((4 + (b) * 2 + (h)) * HTB)
#define PG8_STAGE(bufoff, gbase, voff) do { _Pragma("unroll") for (int _i = 0; _i < 2; ++_i) \
        __builtin_amdgcn_global_load_lds((const unsigned*)((const char*)(gbase) + (voff)[_i]), (LAS unsigned*)(lds + (bufoff) + ldsw + _i * 8192), 16, 0, 0); } while (0)
#define PG8_STAGEB(bufoff, gbase, voff) do { _Pragma("unroll") for (int _i = 0; _i < 2; ++_i) \
        __builtin_amdgcn_global_load_lds((const unsigned*)((const char*)(gbase) + (voff)[_i]), (LAS unsigned*)(lds + (bufoff) + ldsw + _i * 8192), 16, 0, P::BAUX); } while (0)
#define PG8_LD2(p_) __builtin_shufflevector(*(const LAS i32x4*)(p_), *(const LAS i32x4*)((p_) + 1024), 0, 1, 2, 3, 4, 5, 6, 7)
#define PG8_LDA(dst, b, h) do { _Pragma("unroll") for (int m = 0; m < 4; ++m) dst[m] = PG8_LD2(lds + PG8_SA(b, h) + aoff + m * 2048); } while (0)
#define PG8_LDB(dst, b, h) do { _Pragma("unroll") for (int n = 0; n < 2; ++n) dst[n] = PG8_LD2(lds + PG8_SB(b, h) + boff + n * 2048); } while (0)
#define PG8_LO(x) __builtin_bit_cast(bf16x8, __builtin_shufflevector((x), (x), 0, 1, 2, 3))
#define PG8_HI(x) __builtin_bit_cast(bf16x8, __builtin_shufflevector((x), (x), 4, 5, 6, 7))
#define PG8_MMA(ai, bj, At, Bt) do { __builtin_amdgcn_s_setprio(1); \
        if constexpr (P::F8) { _Pragma("unroll") for (int m = 0; m < 4; ++m) _Pragma("unroll") for (int n = 0; n < 2; ++n) \
            asm volatile("v_mfma_f32_16x16x128_f8f6f4 %0, %1, %2, %0" : "+v"(acc[ai][bj][m][n]) : "v"(Bt[n]), "v"(At[m])); }   \
        else { _Pragma("unroll") for (int m = 0; m < 4; ++m) _Pragma("unroll") for (int n = 0; n < 2; ++n) { \
            acc[ai][bj][m][n] = __builtin_amdgcn_mfma_f32_16x16x32_bf16(PG8_LO(Bt[n]), PG8_LO(At[m]), acc[ai][bj][m][n], 0, 0, 0); \
            acc[ai][bj][m][n] = __builtin_amdgcn_mfma_f32_16x16x32_bf16(PG8_HI(Bt[n]), PG8_HI(At[m]), acc[ai][bj][m][n], 0, 0, 0); } } \
        __builtin_amdgcn_s_setprio(0); } while (0)
#define PG8_WAIT_V(n) asm volatile("s_waitcnt vmcnt(" #n ")" ::: "memory")
#define PG8_WAIT_L(n) asm volatile("s_waitcnt lgkmcnt(" #n ")" ::: "memory")
#define PG8_BAR __builtin_amdgcn_s_barrier()
#define PG8_SCHED __builtin_amdgcn_sched_barrier(0)
#define PG8_ZERO() do { _Pragma("unroll") for (int a = 0; a < 2; ++a) _Pragma("unroll") for (int b = 0; b < 2; ++b) _Pragma("unroll") for (int m = 0; m < 4; ++m) _Pragma("unroll") for (int n = 0; n < 2; ++n) acc[a][b][m][n] = (f32x4){0.f, 0.f, 0.f, 0.f}; } while (0)
    GUnit cur, nxt; int ui = 0;
    if (!S.next(0, cur)) return;
    f32x4 acc[2][2][4][2];
    PG8_ZERO();
    i32x8 At[4], B0[2], B1[2];
    unsigned oaC[2], obC[2], oaN[2], obN[2], oaC1[2], oaN1[2];
    unsigned lda2 = P::VARP ? cur.lda2 : P::LDA2, ldb2 = P::VARP ? cur.ldb2 : P::LDB2;
#pragma unroll
    for (int i = 0; i < 2; ++i) { oaC[i] = (unsigned)sRA[i] * lda2 + (unsigned)sC[i]; obC[i] = (unsigned)sRB[i] * ldb2 + (unsigned)sC[i]; oaN[i] = oaC[i]; obN[i] = obC[i]; oaC1[i] = oaC[i]; oaN1[i] = oaC[i]; }
    if constexpr (P::GATHER) {
#pragma unroll
        for (int i = 0; i < 2; ++i) { oaC[i] = (unsigned)S.arow(cur, sRA[i]) * lda2 + (unsigned)sC[i]; oaC1[i] = (unsigned)S.arow(cur, ((P::HALFU && cur.hm) ? 0 : HALF) + sRA[i]) * lda2 + (unsigned)sC[i]; } }
    const char* cA = cur.A; const char* cB = cur.B; size_t hA = (P::GATHER || (P::HALFU && cur.hm)) ? (size_t)0 : (size_t)HALF * lda2, hB = (size_t)HALF * ldb2;
    if constexpr (P::HOOK) S.a_ready(cur, wid, lane);
    PG8_STAGEB(PG8_SB(0, 0), cB, obC); PG8_STAGE(PG8_SA(0, 0), cA, oaC); PG8_STAGEB(PG8_SB(0, 1), cB + hB, obC); PG8_STAGE(PG8_SA(0, 1), cA + hA, oaC1);
    if (wr == 1) PG8_BAR;
    PG8_WAIT_V(4); PG8_BAR;
    PG8_STAGEB(PG8_SB(1, 0), cB + kstep, obC); PG8_STAGE(PG8_SA(1, 0), cA + kstep, oaC); PG8_STAGEB(PG8_SB(1, 1), cB + hB + kstep, obC);
    PG8_WAIT_V(6); PG8_BAR;
    for (;;) {
        const bool has_next = S.next(ui + 1, nxt);
        const char* nA = has_next ? nxt.A : cA; const char* nB = has_next ? nxt.B : cB; size_t hAn = hA, hBn = hB;
        if constexpr (P::HALFU && !P::GATHER) { if (has_next) hAn = nxt.hm ? (size_t)0 : (size_t)HALF * lda2; }
        const bool hf = P::HALFU && cur.hm != 0;
        if constexpr (P::VARP) {
#pragma unroll
            for (int i = 0; i < 2; ++i) { oaN[i] = oaC[i]; obN[i] = obC[i]; }
            if (has_next) { hAn = (size_t)HALF * nxt.lda2; hBn = (size_t)HALF * nxt.ldb2;
#pragma unroll
                for (int i = 0; i < 2; ++i) { oaN[i] = (unsigned)sRA[i] * nxt.lda2 + (unsigned)sC[i]; obN[i] = (unsigned)sRB[i] * nxt.ldb2 + (unsigned)sC[i]; } } }
        if constexpr (P::GATHER) {
#pragma unroll
            for (int i = 0; i < 2; ++i) { oaN[i] = oaC[i]; oaN1[i] = oaC1[i]; }
            if (has_next) {
#pragma unroll
                for (int i = 0; i < 2; ++i) { oaN[i] = (unsigned)S.arow(nxt, sRA[i]) * lda2 + (unsigned)sC[i]; oaN1[i] = (unsigned)S.arow(nxt, ((P::HALFU && nxt.hm) ? 0 : HALF) + sRA[i]) * lda2 + (unsigned)sC[i]; } } }
        const int nt = P::VARP ? cur.nt : P::NT;
        for (int seg = 0; seg < (P::MID > 0 ? 2 : 1); ++seg) {
        const int t_lo = (P::MID > 0 && seg == 1) ? P::MID : 0, t_hi = (P::MID > 0 && seg == 0) ? P::MID : nt;
        for (int t = t_lo; t < t_hi; t += 2) {
            const bool last = (t == nt - 2);
            if constexpr (P::HOOK) { if (last && has_next) S.a_ready(nxt, wid, lane); }
            const char* a1 = cA + (size_t)(t + 1) * kstep;
            const char* a2 = last ? nA : cA + (size_t)(t + 2) * kstep; const char* b2 = last ? nB : cB + (size_t)(t + 2) * kstep;
            const char* a3 = a2 + kstep; const char* b3 = b2 + kstep;
            size_t h2A = hA, h2B = hB; unsigned oa2[2], ob2[2];
            if constexpr (P::HALFU) h2A = last ? hAn : hA;
#pragma unroll
            for (int i = 0; i < 2; ++i) { oa2[i] = oaC[i]; ob2[i] = obC[i]; }
            unsigned oa21[2];
#pragma unroll
            for (int i = 0; i < 2; ++i) oa21[i] = oa2[i];
            if constexpr (P::VARP) { h2A = last ? hAn : hA; h2B = last ? hBn : hB;
#pragma unroll
                for (int i = 0; i < 2; ++i) { oa2[i] = last ? oaN[i] : oaC[i]; ob2[i] = last ? obN[i] : obC[i]; oa21[i] = oa2[i]; } }
            if constexpr (P::GATHER) {
#pragma unroll
                for (int i = 0; i < 2; ++i) { oa2[i] = last ? oaN[i] : oaC[i]; oa21[i] = last ? oaN1[i] : oaC1[i]; } }
            PG8_LDB(B0, 0, 0); PG8_SCHED; PG8_LDA(At, 0, 0); PG8_STAGE(PG8_SA(1, 1), a1 + hA, oaC1);
            PG8_WAIT_L(8); PG8_BAR; PG8_WAIT_L(0); PG8_MMA(0, 0, At, B0); PG8_BAR; PG8_SCHED;
            PG8_LDB(B1, 0, 1); PG8_STAGEB(PG8_SB(0, 0), b2, ob2);
            PG8_BAR; PG8_WAIT_L(0); PG8_MMA(0, 1, At, B1); PG8_BAR;
            if (!hf) PG8_LDA(At, 0, 1); PG8_STAGE(PG8_SA(0, 0), a2, oa2);
            PG8_BAR; PG8_WAIT_L(0); if (!hf) PG8_MMA(1, 0, At, B0); PG8_BAR; PG8_SCHED;
            PG8_STAGEB(PG8_SB(0, 1), b2 + h2B, ob2);
            PG8_WAIT_V(6); PG8_BAR; if (!hf) PG8_MMA(1, 1, At, B1); PG8_BAR;
            PG8_LDB(B0, 1, 0); PG8_SCHED; PG8_LDA(At, 1, 0); PG8_STAGE(PG8_SA(0, 1), a2 + h2A, oa21);
            PG8_WAIT_L(8); PG8_BAR; PG8_WAIT_L(0); PG8_MMA(0, 0, At, B0); PG8_BAR; PG8_SCHED;
            PG8_LDB(B1, 1, 1); PG8_STAGEB(PG8_SB(1, 0), b3, ob2);
            PG8_BAR; PG8_WAIT_L(0); PG8_MMA(0, 1, At, B1); PG8_BAR;
            if (!hf) PG8_LDA(At, 1, 1); PG8_STAGE(PG8_SA(1, 0), a3, oa2);
            PG8_BAR; PG8_WAIT_L(0); if (!hf) PG8_MMA(1, 0, At, B0); PG8_BAR; PG8_SCHED;
            PG8_STAGEB(PG8_SB(1, 1), b3 + h2B, ob2);
            PG8_WAIT_V(6); PG8_BAR; if (!hf) PG8_MMA(1, 1, At, B1); PG8_BAR;
        }
        if constexpr (P::MID > 0) { if (seg == 0) { if constexpr (P::F8) asm volatile("s_nop 15\n\ts_nop 15" ::: "memory"); int fr2 = fr, fq2 = fq; asm volatile("" : "+v"(fr2), "+v"(fq2)); S.mid(acc, cur, wr, wc, fr2, fq2); } }
        }
        if constexpr (P::ALIGN) { if (wr == 0) PG8_BAR; }
        if constexpr (P::F8) asm volatile("s_nop 15\n\ts_nop 15" ::: "memory");
        int fr2 = fr, fq2 = fq; asm volatile("" : "+v"(fr2), "+v"(fq2));
        const bool z = S.epi(acc, cur, wr, wc, fr2, fq2);
        if (!has_next) break;
        if (z) PG8_ZERO();
        cur = nxt; cA = nA; cB = nB;
        if constexpr (P::VARP) { hA = hAn; hB = hBn;
#pragma unroll
            for (int i = 0; i < 2; ++i) { oaC[i] = oaN[i]; obC[i] = obN[i]; } }
        if constexpr (P::HALFU) hA = hAn;
        if constexpr (P::GATHER) {
#pragma unroll
            for (int i = 0; i < 2; ++i) { oaC[i] = oaN[i]; oaC1[i] = oaN1[i]; } }
        ++ui;
        if constexpr (P::ALIGN) { if (wr == 1) PG8_BAR; }
    }
    PG8_WAIT_V(0);
    if constexpr (!P::ALIGN) { if (wr == 0) PG8_BAR; }
    PG8_BAR;
#undef PG8_SA
#undef PG8_SB
#undef PG8_STAGE
#undef PG8_STAGEB
#undef PG8_LDA
#undef PG8_LDB
#undef PG8_MMA
#undef PG8_LD2
#undef PG8_LO
#undef PG8_HI
#undef PG8_WAIT_V
#undef PG8_WAIT_L
#undef PG8_BAR
#undef PG8_SCHED
#undef PG8_ZERO
}
}
using pg8::GUnit;

struct ProbInProj {
    static constexpr int BAUX = 0; static constexpr bool HALFU = HALF_UNITS != 0; static constexpr bool HOOK = false; static constexpr bool GATHER = false; static constexpr bool ALIGN = true; static constexpr bool F8 = F8_IN; static constexpr int EB = F8 ? 1 : 2;
    static constexpr int MID = 0; static constexpr bool PERM = true, VARP = false; static constexpr unsigned LDA2 = D * EB, LDB2 = D * EB; static constexpr int NT = D * EB / 128;
    const u16* A; const u16* Bt; int G, c;
    unsigned char* ws; float* gkl; const float* tab;
    __device__ __forceinline__ bool next(int i, GUnit& u) const {
        constexpr int nM = T / 256, nN = NWIN / 256, nwg = nM * nN;
        int L, hm; if (!pg8::deal(i, c, G, nwg, HALFU, L, hm)) return false;
        int pm, pn; pg8::tile_of(pg8::xcd_remap(L, nwg), nM, nN, pm, pn);
        u.A = (const char*)A + ((size_t)pm * 256 + (hm == 2 ? 128 : 0)) * D * EB; u.B = (const char*)Bt + (size_t)pn * 256 * D * EB; u.lda2 = LDA2; u.ldb2 = LDB2; u.nt = NT; u.pm = pm; u.pn = pn; u.aux = 0; u.hm = hm;
        return true;
    }
    __device__ __forceinline__ bool epi(f32x4 (&acc)[2][2][4][2], const GUnit& u, int wr, int wc, int fr, int fq) const {
#ifdef PROBE_DOUBLEK
        if (u.aux == 0) return false;
#pragma unroll
        for (int ai = 0; ai < 2; ++ai)
#pragma unroll
            for (int bj = 0; bj < 2; ++bj)
#pragma unroll
                for (int m = 0; m < 4; ++m)
#pragma unroll
                    for (int n = 0; n < 2; ++n) acc[ai][bj][m][n] = acc[ai][bj][m][n] * 0.5f;
#endif
        if constexpr (F8) {
#pragma unroll
            for (int ai = 0; ai < 2; ++ai)
#pragma unroll
                for (int bj = 0; bj < 2; ++bj)
#pragma unroll
                    for (int m = 0; m < 4; ++m)
#pragma unroll
                        for (int n = 0; n < 2; ++n) acc[ai][bj][m][n] = acc[ai][bj][m][n] * F8_INV; }
        const int pn = u.pn; int mode, ld, colt; size_t boff;
        if (pn < 18) { const int q = pn / 6; boff = P_QA + (size_t)q * (P_KA - P_QA); ld = 1536; colt = 256 * (pn - 6 * q); mode = q == 0 ? 1 : (q == 1 ? 2 : 0); }
        else if (pn < 26) { const int q = (pn - 18) / 4; boff = P_QB + (size_t)q * (P_KB - P_QB); ld = 1024; colt = 256 * ((pn - 18) - 4 * q); mode = 0; }
        else if (pn < 58) { const int q = (pn - 26) / 8; boff = P_VB + (size_t)q * (P_RB - P_VB); ld = 2048; colt = 256 * ((pn - 26) - 8 * q); mode = q == 0 ? 0 : (q == 1 ? 3 : 4); }
        else { boff = P_QA; ld = 0; colt = 0; mode = 5; }
        u16* base = (u16*)(ws + boff);
        const __amdgpu_buffer_rsrc_t rs = __builtin_amdgcn_make_buffer_rsrc(ws, 0, (int)0x7fffffff, 0x00020000);
        const int row0 = u.pm * 256 + (u.hm == 2 ? 128 : 0) + wr * 64 + fr, cl = wc * 32 + 8 * fq; const int nai = u.hm ? 1 : 2;
        if (mode == 5) {
            if (wc == 0 && fq < 2) {
#pragma unroll
                for (int ai = 0; ai < 2; ++ai) if (ai < nai)
#pragma unroll
                    for (int m = 0; m < 4; ++m) { float* g = gkl + (size_t)(row0 + ai * 128 + m * 16) * 16 + 8 * fq; *(f32x4*)g = acc[ai][0][m][0]; *(f32x4*)(g + 4) = acc[ai][0][m][1]; } }
            return true; }
        const bool rope = (mode == 1 || mode == 2) && wc == 0;
        const float sgn = fq < 2 ? -1.f : 1.f;
#pragma unroll
        for (int ai = 0; ai < 2; ++ai) { if (ai >= nai) break;
            f32x4 tb[4][4];
            if (rope) {
#pragma unroll
                for (int m = 0; m < 4; ++m) { const f32x4* tp = (const f32x4*)(tab + ((size_t)(row0 + ai * 128 + m * 16) * 16 + 8 * (fq & 1)) * 2); tb[m][0] = tp[0]; tb[m][1] = tp[1]; tb[m][2] = tp[2]; tb[m][3] = tp[3]; }
                asm volatile("" ::: "memory"); }
#pragma unroll
            for (int m = 0; m < 4; ++m) { const int row = row0 + ai * 128 + m * 16; u16* rowp = base + (size_t)row * ld + colt + cl;
#pragma unroll
                for (int bj = 0; bj < 2; ++bj) { f32x4 v0 = acc[ai][bj][m][0], v1 = acc[ai][bj][m][1];
                    if (rope) { const f32x4 t0 = tb[m][0], t1 = tb[m][1], t2 = tb[m][2], t3 = tb[m][3]; f32x4 o0, o1;
#pragma unroll
                        for (int j = 0; j < 4; ++j) { o0[j] = sgn * __shfl_xor(v0[j], 32); o1[j] = sgn * __shfl_xor(v1[j], 32); }
                        v0 = (f32x4){v0[0] * t0[0] + o0[0] * t0[1], v0[1] * t0[2] + o0[1] * t0[3], v0[2] * t1[0] + o0[2] * t1[1], v0[3] * t1[2] + o0[3] * t1[3]};
                        v1 = (f32x4){v1[0] * t2[0] + o1[0] * t2[1], v1[1] * t2[2] + o1[1] * t2[3], v1[2] * t3[0] + o1[2] * t3[1], v1[3] * t3[2] + o1[3] * t3[3]}; }
                    if (mode == 1) { v0 = v0 * 0.08838834764831845f; v1 = v1 * 0.08838834764831845f; }
                    if (mode == 3) {
#pragma unroll
                        for (int j = 0; j < 4; ++j) { v0[j] = v0[j] * fsigmoid(v0[j]); v1[j] = v1[j] * fsigmoid(v1[j]); } }
                    if (mode == 4) {
#pragma unroll
                        for (int j = 0; j < 4; ++j) { v0[j] = fsigmoid(v0[j]); v1[j] = fsigmoid(v1[j]); } }
                    u32x4 w; w.x = cvtpk(v0[0], v0[1]); w.y = cvtpk(v0[2], v0[3]); w.z = cvtpk(v1[0], v1[1]); w.w = cvtpk(v1[2], v1[3]);
                    if (WT_STORES) __builtin_amdgcn_raw_buffer_store_b128(w, rs, (unsigned)(boff + ((size_t)row * ld + colt + cl + bj * 128) * 2), 0, 16); else *(u32x4*)(rowp + bj * 128) = w; } }
            asm volatile("" ::: "memory"); }
        return true;
    }
};
struct ProbMerge {
    static constexpr int BAUX = 0; static constexpr bool HALFU = false; static constexpr bool HOOK = false; static constexpr bool GATHER = false; static constexpr bool ALIGN = false; static constexpr bool F8 = (USE_F8 & 8) != 0; static constexpr int EB = F8 ? 1 : 2; static constexpr int MID = 512 * EB / 128; static constexpr bool PERM = true, VARP = false; static constexpr unsigned LDA2 = KAB * EB, LDB2 = KAB * EB; static constexpr int NT = KAB * EB / 128;
    const u16 *yab, *PabT, *Ga, *Gb; u16* mrg; int G, c;
    __device__ __forceinline__ bool next(int i, GUnit& u) const {
        constexpr int nM = T / 256, nN = D / 256, nwg = nM * nN;
        const long L = (long)i * G + c; if (L >= nwg) return false;
        int pm, pn; pg8::tile_of(pg8::xcd_remap((int)L, nwg), nM, nN, pm, pn); u.pm = pm; u.pn = pn; u.aux = 0;
        u.A = (const char*)yab + (size_t)pm * 256 * KAB * EB; u.B = (const char*)PabT + (size_t)pn * 256 * KAB * EB; u.lda2 = LDA2; u.ldb2 = LDB2; u.nt = NT; u.hm = 0; return true;
    }
    __device__ __forceinline__ void mid(f32x4 (&acc)[2][2][4][2], const GUnit& u, int wr, int wc, int fr, int fq) const {
        const int row0 = u.pm * 256 + wr * 64 + fr, col0 = u.pn * 256 + wc * 32 + 8 * fq;
#pragma unroll
        for (int ai = 0; ai < 2; ++ai) {
            u32x4 gav[4][2], gbv[4][2];
#pragma unroll
            for (int m = 0; m < 4; ++m) { const size_t ro = (size_t)(row0 + ai * 128 + m * 16) * D + col0;
#pragma unroll
                for (int bj = 0; bj < 2; ++bj) { gbv[m][bj] = *(const u32x4*)(Gb + ro + bj * 128); gav[m][bj] = *(const u32x4*)(Ga + ro + bj * 128); } }
            asm volatile("" ::: "memory");
#pragma unroll
            for (int m = 0; m < 4; ++m)
#pragma unroll
                for (int bj = 0; bj < 2; ++bj) { const u32x4 gb = gbv[m][bj], ga = gav[m][bj];
                    const float b[8] = {bflo(gb.x), bfhi(gb.x), bflo(gb.y), bfhi(gb.y), bflo(gb.z), bfhi(gb.z), bflo(gb.w), bfhi(gb.w)};
                    const float a[8] = {bflo(ga.x), bfhi(ga.x), bflo(ga.y), bfhi(ga.y), bflo(ga.z), bfhi(ga.z), bflo(ga.w), bfhi(ga.w)};
#pragma unroll
                    for (int j = 0; j < 4; ++j) { acc[ai][bj][m][0][j] *= a[j] * __builtin_amdgcn_rcpf(b[j]); acc[ai][bj][m][1][j] *= a[4 + j] * __builtin_amdgcn_rcpf(b[4 + j]); } }
            asm volatile("" ::: "memory"); }
    }
    __device__ __forceinline__ bool epi(f32x4 (&acc)[2][2][4][2], const GUnit& u, int wr, int wc, int fr, int fq) const {
        const int row0 = u.pm * 256 + wr * 64 + fr, col0 = u.pn * 256 + wc * 32 + 8 * fq;
#pragma unroll
        for (int ai = 0; ai < 2; ++ai) {
            u32x4 gbv[4][2];
#pragma unroll
            for (int m = 0; m < 4; ++m) { const size_t ro = (size_t)(row0 + ai * 128 + m * 16) * D + col0;
#pragma unroll
                for (int bj = 0; bj < 2; ++bj) gbv[m][bj] = *(const u32x4*)(Gb + ro + bj * 128); }
            asm volatile("" ::: "memory");
#pragma unroll
            for (int m = 0; m < 4; ++m) { const size_t ro = (size_t)(row0 + ai * 128 + m * 16) * D + col0;
#pragma unroll
                for (int bj = 0; bj < 2; ++bj) { const u32x4 gb = gbv[m][bj];
                    const float b[8] = {bflo(gb.x), bfhi(gb.x), bflo(gb.y), bfhi(gb.y), bflo(gb.z), bfhi(gb.z), bflo(gb.w), bfhi(gb.w)};
                    const f32x4 v0 = acc[ai][bj][m][0], v1 = acc[ai][bj][m][1];
                    if (F8_WO) { constexpr float sc = F8_ACT * (F8 ? F8_INV : 1.f); u32x2 w8; w8.x = cvt4_f8(v0[0] * b[0] * sc, v0[1] * b[1] * sc, v0[2] * b[2] * sc, v0[3] * b[3] * sc); w8.y = cvt4_f8(v1[0] * b[4] * sc, v1[1] * b[5] * sc, v1[2] * b[6] * sc, v1[3] * b[7] * sc);
                        *(u32x2*)((unsigned char*)mrg + ro + bj * 128) = w8; }
                    else { constexpr float sc = F8 ? F8_INV : 1.f; u32x4 w; w.x = cvtpk(v0[0] * b[0] * sc, v0[1] * b[1] * sc); w.y = cvtpk(v0[2] * b[2] * sc, v0[3] * b[3] * sc); w.z = cvtpk(v1[0] * b[4] * sc, v1[1] * b[5] * sc); w.w = cvtpk(v1[2] * b[6] * sc, v1[3] * b[7] * sc);
                        *(u32x4*)(mrg + ro + bj * 128) = w; } } }
            asm volatile("" ::: "memory"); }
        return true;
    }
};
struct ProbWo {
    static constexpr int BAUX = 0; static constexpr bool HALFU = false; static constexpr bool HOOK = false; static constexpr bool GATHER = false; static constexpr bool ALIGN = false; static constexpr bool F8 = (USE_F8 & 4) != 0; static constexpr int EB = F8 ? 1 : 2; static constexpr int MID = 0; static constexpr bool PERM = false, VARP = false; static constexpr unsigned LDA2 = D * EB, LDB2 = D * EB; static constexpr int NT = D * EB / 128;
    const u16 *A, *Bt; const void* hres; u16* pre1; int hres_bf16; int G, c;
    __device__ __forceinline__ bool next(int i, GUnit& u) const {
        constexpr int nM = T / 256, nN = D / 256, nwg = nM * nN;
        const long L = (long)i * G + c; if (L >= nwg) return false;
        int pm, pn; pg8::tile_of(pg8::xcd_remap((int)L, nwg), nM, nN, pm, pn);
        u.A = (const char*)A + (size_t)pm * 256 * D * EB; u.B = (const char*)Bt + (size_t)pn * 256 * D * EB; u.lda2 = LDA2; u.ldb2 = LDB2; u.nt = NT; u.pm = pm; u.pn = pn; u.aux = 0; u.hm = 0; return true;
    }
    __device__ __forceinline__ bool epi(f32x4 (&acc)[2][2][4][2], const GUnit& u, int wr, int wc, int fr, int fq) const {
        const int row0 = u.pm * 256 + wr * 64 + fr, col0 = u.pn * 256 + wc * 32 + 4 * fq;
#pragma unroll
        for (int ai = 0; ai < 2; ++ai) {
            f32x4 hv[4][2][2];
            if (hres_bf16) {
#pragma unroll
                for (int m = 0; m < 4; ++m) { const size_t ro = (size_t)(row0 + ai * 128 + m * 16) * D + col0;
#pragma unroll
                    for (int bj = 0; bj < 2; ++bj)
#pragma unroll
                        for (int n = 0; n < 2; ++n) { const u32x2 q = *(const u32x2*)((const u16*)hres + ro + bj * 128 + n * 16); hv[m][bj][n] = (f32x4){bflo(q.x), bfhi(q.x), bflo(q.y), bfhi(q.y)}; } } }
            else {
#pragma unroll
                for (int m = 0; m < 4; ++m) { const size_t ro = (size_t)(row0 + ai * 128 + m * 16) * D + col0;
#pragma unroll
                    for (int bj = 0; bj < 2; ++bj)
#pragma unroll
                        for (int n = 0; n < 2; ++n) hv[m][bj][n] = *(const f32x4*)((const float*)hres + ro + bj * 128 + n * 16); } }
            asm volatile("" ::: "memory");
#pragma unroll
            for (int m = 0; m < 4; ++m) { const size_t ro = (size_t)(row0 + ai * 128 + m * 16) * D + col0;
#pragma unroll
                for (int bj = 0; bj < 2; ++bj)
#pragma unroll
                    for (int n = 0; n < 2; ++n) { const f32x4 o = hv[m][bj][n] * DN_ALPHA + acc[ai][bj][m][n] * (F8 ? F8_INV : 1.f); u32x2 w; w.x = cvtpk(o[0], o[1]); w.y = cvtpk(o[2], o[3]); *(u32x2*)(pre1 + ro + bj * 128 + n * 16) = w; } }
            asm volatile("" ::: "memory"); }
        return true;
    }
};
__device__ __forceinline__ void moe_prefix(const int* cnt, int lane, int (&pre)[17], int (&cn)[16]) {
    int cv = 0; if (lane < 16) cv = __hip_atomic_load(cnt + 64 * lane, __ATOMIC_RELAXED, __HIP_MEMORY_SCOPE_AGENT);
    int s = (cv + 255) >> 8;
#pragma unroll
    for (int o = 1; o < 16; o <<= 1) { const int t = __shfl_up(s, o); if (lane >= o) s += t; }
    pre[0] = 0;
#pragma unroll
    for (int e = 0; e < 16; ++e) { pre[e + 1] = __builtin_amdgcn_readlane(s, e); cn[e] = __builtin_amdgcn_readlane(cv, e); }
}
template <int NT>
__device__ __forceinline__ void moe_decode(const int (&pre)[17], int L, int& e, int& j, int& prow) {
    int ee = 0;
#pragma unroll
    for (int k = 1; k < 16; ++k) ee += (L >= pre[k] * NT) ? 1 : 0;
    int pb = 0, np = 1;
#pragma unroll
    for (int k = 0; k < 16; ++k) { if (ee == k) { pb = pre[k]; np = pre[k + 1] - pre[k]; } }
    const int rem = L - pb * NT; e = ee; j = rem / np; prow = pb + (rem % np);
}
constexpr int ACTP = F8_MOE ? 1536 : DFF;
struct ProbGateUp {
    static constexpr int BAUX = BAUX_MOE; static constexpr bool HALFU = HALF_UNITS != 0; static constexpr bool HOOK = false; static constexpr bool GATHER = true; static constexpr bool ALIGN = true; static constexpr bool F8 = F8_MOE; static constexpr int EB = F8 ? 1 : 2;
    static constexpr int MID = 0; static constexpr bool PERM = true, VARP = false; static constexpr unsigned LDA2 = D * EB, LDB2 = D * EB; static constexpr int NT = D * EB / 128;
    const u16 *Xg, *Wgu; u16* act; const int* tok; unsigned* pcnt; int pre[17]; int G, c;
    __device__ __forceinline__ bool next(int i, GUnit& u) const {
        const int nwg = pre[16] * 11; int L, hm; if (!pg8::deal(i, c, G, nwg, HALFU, L, hm)) return false;
        int e, j, prow; moe_decode<11>(pre, pg8::xcd_remap(L, nwg), e, j, prow);
        int pb = 0;
#pragma unroll
        for (int k = 0; k < 16; ++k) { if (e == k) pb = pre[k]; }
        u.A = (const char*)Xg; u.B = (const char*)Wgu + ((size_t)e * 2816 + (size_t)j * 256) * D * EB; u.lda2 = (unsigned)(e * 8192 + (prow - pb) * 256 + (hm == 2 ? 128 : 0)); u.ldb2 = LDB2; u.nt = NT; u.pm = prow; u.pn = j; u.aux = e; u.hm = hm; return true;
    }
    __device__ __forceinline__ int arow(const GUnit& u, int r) const { return tok[u.lda2 + r]; }
    __device__ __forceinline__ bool epi(f32x4 (&acc)[2][2][4][2], const GUnit& u, int wr, int wc, int fr, int fq) const {
        const int row0 = u.pm * 256 + (u.hm == 2 ? 128 : 0) + wr * 64 + fr, col0 = u.pn * 128 + wc * 32 + 8 * fq; const int nai = u.hm ? 1 : 2;
#pragma unroll
        for (int ai = 0; ai < 2; ++ai) if (ai < nai)
#pragma unroll
            for (int m = 0; m < 4; ++m) { const f32x4 g0 = acc[ai][0][m][0], g1 = acc[ai][0][m][1], u0 = acc[ai][1][m][0], u1 = acc[ai][1][m][1]; f32x4 r0, r1;
#pragma unroll
                for (int j = 0; j < 4; ++j) { const float ga = g0[j] * (F8 ? F8_INV : 1.f), gb = g1[j] * (F8 ? F8_INV : 1.f); r0[j] = ga * fsigmoid(ga) * (u0[j] * (F8 ? F8_INV : 1.f)); r1[j] = gb * fsigmoid(gb) * (u1[j] * (F8 ? F8_INV : 1.f)); }
                if constexpr (F8) { unsigned char* ap = (unsigned char*)act + (size_t)(row0 + ai * 128 + m * 16) * ACTP;
                    u32x2 w; w.x = cvt4_f8(r0[0] * F8_ACT, r0[1] * F8_ACT, r0[2] * F8_ACT, r0[3] * F8_ACT); w.y = cvt4_f8(r1[0] * F8_ACT, r1[1] * F8_ACT, r1[2] * F8_ACT, r1[3] * F8_ACT);
                    if (MOE_CHAIN) { __hip_atomic_store((unsigned long long*)(ap + col0), (unsigned long long)w.x | ((unsigned long long)w.y << 32), __ATOMIC_RELAXED, __HIP_MEMORY_SCOPE_AGENT);
                        if (u.pn == 10) __hip_atomic_store((unsigned long long*)(ap + DFF + wc * 32 + 8 * fq), 0ull, __ATOMIC_RELAXED, __HIP_MEMORY_SCOPE_AGENT); }
                    else { *(u32x2*)(ap + col0) = w;
                        if (u.pn == 10) { unsigned z0 = 0u; asm volatile("" : "+v"(z0)); *(u32x2*)(ap + DFF + wc * 32 + 8 * fq) = (u32x2){z0, z0}; } } }
                else { u32x4 w; w.x = cvtpk(r0[0], r0[1]); w.y = cvtpk(r0[2], r0[3]); w.z = cvtpk(r1[0], r1[1]); w.w = cvtpk(r1[2], r1[3]);
                    *(u32x4*)(act + (size_t)(row0 + ai * 128 + m * 16) * DFF + col0) = w; } }
        if (MOE_CHAIN) { asm volatile("s_waitcnt vmcnt(0)" ::: "memory");
            if (fr == 0 && fq == 0) __hip_atomic_fetch_add(pcnt + 64 * u.pm, 1u, __ATOMIC_RELAXED, __HIP_MEMORY_SCOPE_AGENT); }
        return true;
    }
};
struct ProbDown {
    static constexpr int BAUX = BAUX_MOE; static constexpr bool HALFU = HALF_UNITS != 0; static constexpr bool HOOK = MOE_CHAIN != 0; static constexpr bool GATHER = false; static constexpr bool ALIGN = true; static constexpr bool F8 = F8_MOE; static constexpr int EB = F8 ? 1 : 2;
    static constexpr int MID = 0; static constexpr bool PERM = true, VARP = false; static constexpr unsigned LDA2 = ACTP * EB, LDB2 = ACTP * EB; static constexpr int NT = ACTP * EB / 128;
    const u16 *act, *Wd; u16* dn; unsigned* pcnt; unsigned* tmo; int pre[17]; int G, c;
    __device__ __forceinline__ bool next(int i, GUnit& u) const {
        const int nwg = pre[16] * 8; int L, hm; if (!pg8::deal(i, MOE_CHAIN ? G - 1 - c : c, G, nwg, HALFU, L, hm)) return false;
        int e, j, prow; moe_decode<8>(pre, pg8::xcd_remap(L, nwg), e, j, prow);
        u.A = (const char*)act + ((size_t)prow * 256 + (hm == 2 ? 128 : 0)) * ACTP * EB; u.B = (const char*)Wd + ((size_t)e * D + (size_t)j * 256) * ACTP * EB; u.lda2 = LDA2; u.ldb2 = LDB2; u.nt = NT; u.pm = prow; u.pn = j; u.aux = e; u.hm = hm; return true;
    }
    __device__ __forceinline__ void a_ready(const GUnit& u, int wid, int lane) const {
        if (wid == 0) { unsigned polls = 0;
            while ((unsigned)__builtin_amdgcn_readfirstlane(__hip_atomic_load(pcnt + 64 * u.pm, __ATOMIC_RELAXED, __HIP_MEMORY_SCOPE_AGENT)) < 88u) {
                if (++polls > (1u << 22)) { if (lane == 0) __hip_atomic_store(tmo, 1u, __ATOMIC_RELAXED, __HIP_MEMORY_SCOPE_AGENT); break; }
                __builtin_amdgcn_s_sleep(2); }
            __builtin_amdgcn_fence(__ATOMIC_ACQUIRE, "agent");
            asm volatile("s_waitcnt vmcnt(0)" ::: "memory"); }
        asm volatile("" ::: "memory"); __builtin_amdgcn_s_barrier(); asm volatile("" ::: "memory");
    }
    __device__ __forceinline__ bool epi(f32x4 (&acc)[2][2][4][2], const GUnit& u, int wr, int wc, int fr, int fq) const {
        const int row0 = u.pm * 256 + (u.hm == 2 ? 128 : 0) + wr * 64 + fr, col0 = u.pn * 256 + wc * 32 + 8 * fq; const int nai = u.hm ? 1 : 2;
#pragma unroll
        for (int ai = 0; ai < 2; ++ai) if (ai < nai)
#pragma unroll
            for (int m = 0; m < 4; ++m) { u16* rowp = dn + (size_t)(row0 + ai * 128 + m * 16) * D + col0;
#pragma unroll
                for (int bj = 0; bj < 2; ++bj) { const f32x4 v0 = acc[ai][bj][m][0] * (F8 ? F8_INV : 1.f), v1 = acc[ai][bj][m][1] * (F8 ? F8_INV : 1.f);
                    if (DN_F8) { u32x2 w8; w8.x = cvt4_f8(v0[0] * 16.f, v0[1] * 16.f, v0[2] * 16.f, v0[3] * 16.f); w8.y = cvt4_f8(v1[0] * 16.f, v1[1] * 16.f, v1[2] * 16.f, v1[3] * 16.f);
                        *(u32x2*)((unsigned char*)dn + (size_t)(row0 + ai * 128 + m * 16) * D + col0 + bj * 128) = w8; }
                    else { u32x4 w; w.x = cvtpk(v0[0], v0[1]); w.y = cvtpk(v0[2], v0[3]); w.z = cvtpk(v1[0], v1[1]); w.w = cvtpk(v1[2], v1[3]);
                        *(u32x4*)(rowp + bj * 128) = w; } } }
        return true;
    }
};

#define XB_TMO      128
#define XB_XCNT(j)  (256  + 64 * (j))
#define XB_XSUB(j)  (1280 + 64 * (j))
#define XB_XGEN(j)  (2304 + 64 * (j))
#define XB_TOP      3328
#define XB_TOPGEN   3392
#define XCD_BAR_WORDS 3456
#define XB_SPIN_CAP (1u << 18)
__device__ __forceinline__ unsigned xb_ld(unsigned* p)              { return __hip_atomic_load(p, __ATOMIC_RELAXED, __HIP_MEMORY_SCOPE_AGENT); }
__device__ __forceinline__ unsigned xb_add(unsigned* p, unsigned v) { return __hip_atomic_fetch_add(p, v, __ATOMIC_RELAXED, __HIP_MEMORY_SCOPE_AGENT); }
__device__ __forceinline__ unsigned xb_xcc_id() { return (unsigned)__builtin_amdgcn_s_getreg((3 << 11) | 20) & 0xFu; }
#define XB_SPIN(cond, bar) do { unsigned _sp = 0; while (cond) { __builtin_amdgcn_s_sleep(1); \
    if ((++_sp & 255u) == 0u) { if (xb_ld(&(bar)[XB_TMO])) break; if (_sp > XB_SPIN_CAP) { atomicAdd(&(bar)[XB_TMO], 1u); break; } } } } while (0)
struct XcdBarrier { unsigned* bar; unsigned x; volatile LAS unsigned* st; };
__device__ __forceinline__ XcdBarrier xcd_barrier_post(unsigned* bar, volatile LAS unsigned* st) {
    XcdBarrier b; b.bar = bar; b.x = xb_xcc_id(); b.st = st;
    if (threadIdx.x == 0) (void)xb_add(&bar[XB_XCNT(b.x)], 1u);
    return b;
}
__device__ __forceinline__ void xcd_barrier_complete(unsigned* bar, unsigned x, unsigned& nloc, unsigned& nx) {
    const unsigned G = gridDim.x * gridDim.y * gridDim.z;
    unsigned sum, cnt, mine, sp = 0u;
    for (;;) {
        sum = 0u; cnt = 0u; mine = 0u;
#pragma unroll
        for (unsigned j = 0; j < 16; ++j) { const unsigned c = xb_ld(&bar[XB_XCNT(j)]); sum += c; cnt += (c > 0u) ? 1u : 0u; mine = (j == x) ? c : mine; }
        if (sum == G) break;
        __builtin_amdgcn_s_sleep(1);
        if ((++sp & 255u) == 0u) { if (xb_ld(&bar[XB_TMO])) break; if (sp > XB_SPIN_CAP) { atomicAdd(&bar[XB_TMO], 1u); break; } }
    }
    nloc = mine > 0u ? mine : 1u; nx = cnt > 0u ? cnt : 1u;
}
__device__ __forceinline__ void xcd_barrier(const XcdBarrier& b, int wv) {
    asm volatile("s_waitcnt vmcnt(0)" ::: "memory");
    __syncthreads();
    if (wv == 0 && lane_id() == 0) {
        unsigned* bar = b.bar; asm volatile("" : "+s"(bar));
        __builtin_amdgcn_s_waitcnt(0);
        unsigned nloc = b.st[0], nx = b.st[1];
        if (nloc == 0u) { xcd_barrier_complete(bar, b.x, nloc, nx); b.st[0] = nloc; b.st[1] = nx; }
        const unsigned old = xb_add(&bar[XB_XSUB(b.x)], 1u);
        const unsigned gen = old / nloc;
        if (old + 1u == (gen + 1u) * nloc) {
            __builtin_amdgcn_fence(__ATOMIC_RELEASE, "agent");
            asm volatile("s_waitcnt vmcnt(0)" ::: "memory");
            const unsigned og = xb_add(&bar[XB_TOP], 1u);
            const unsigned tg = og / nx;
            if (og + 1u == (tg + 1u) * nx) xb_add(&bar[XB_TOPGEN], 1u);
            else XB_SPIN(xb_ld(&bar[XB_TOPGEN]) == tg, bar);
            __builtin_amdgcn_fence(__ATOMIC_ACQUIRE, "agent");
            xb_add(&bar[XB_XGEN(b.x)], 1u);
            asm volatile("s_waitcnt vmcnt(0)" ::: "memory");
        } else {
            XB_SPIN(xb_ld(&bar[XB_XGEN(b.x)]) == gen, bar);
            __builtin_amdgcn_fence(__ATOMIC_ACQUIRE, "agent");
            asm volatile("s_waitcnt vmcnt(0)" ::: "memory");
        }
    }
    __syncthreads();
}

struct Args {
    const float* x; const int* pos; const float* w_in; const float* w_gk2; const float* b_gk; const float* g_gla; const float* p_a; const float* p_b; const float* w_o;
    const float* ln1_g; const float* ln1_b; const float* router_w; const float* router_b; const float* w_gate; const float* w_up; const float* w_down; const float* ln2_g; const float* ln2_b;
    float* out; unsigned char* ws; int ph_lo, ph_hi;
};
constexpr int CW_PANEL = 16384  ;
constexpr int CW_TMO = 0, CW_CNT = 8192  , CW_BAR = 4096;
constexpr int NPH_LAYER = 11, NPH = 1 + 2 * NPH_LAYER;

struct TrItem { const float* src; unsigned char* dst; int ldn, N, ldd, k0, n0, mode, esz; };
static_assert(!(F8_MRG && GLA_SIMPLE), "the simple GLA path writes bf16 y_b");
constexpr int WEB_IN = F8_IN ? 1 : 2, WEB = F8_MOE ? 1 : 2, WEB_WO = F8_WO ? 1 : 2, WEB_MRG = F8_MRG ? 1 : 2;
__device__ __forceinline__ void tr_decode(const Args& a, int it, TrItem& q) {
    constexpr int NT_IN = (NIN + 63) / 64;
    constexpr int I_WIN = 32 * NT_IN, I_PA = 8 * 32, I_PB = 32 * 32, I_WO = 32 * 32, I_WG = NE * 32 * 22, I_WD = NE * 22 * 32, I_LAYER = I_WIN + I_PA + I_PB + I_WO + 2 * I_WG + I_WD;
    unsigned char* ws = a.ws; const int l = it / I_LAYER; int r = it % I_LAYER;
    if (r < I_WIN) { const int kt = 2 * ((r >> 1) / NT_IN) + (r & 1), nt = (r >> 1) % NT_IN; q = TrItem{a.w_in + (size_t)l * D * NIN, ws + WS_WIN + l * SZ_WIN, NIN, NIN, D, 64 * kt, 64 * nt, 0, WEB_IN}; return; } r -= I_WIN;
    if (r < I_PA) { const int kt = 2 * ((r >> 1) / 32) + (r & 1), nt = (r >> 1) % 32; q = TrItem{a.p_a + (size_t)l * 512 * D, ws + WS_PAB + l * SZ_PAB, D, D, KAB, 64 * kt, 64 * nt, 1, WEB_MRG}; return; } r -= I_PA;
    if (r < I_PB) { const int kt = 2 * ((r >> 1) / 32) + (r & 1), nt = (r >> 1) % 32; q = TrItem{a.p_b + (size_t)l * D * D, ws + WS_PAB + l * SZ_PAB + 512 * WEB_MRG, D, D, KAB, 64 * kt, 64 * nt, 1, WEB_MRG}; return; } r -= I_PB;
    if (r < I_WO) { const int kt = 2 * ((r >> 1) / 32) + (r & 1), nt = (r >> 1) % 32; q = TrItem{a.w_o + (size_t)l * D * D, ws + WS_WO + l * SZ_WO, D, D, D, 64 * kt, 64 * nt, 1, WEB_WO}; return; } r -= I_WO;
    if (r < I_WG) { const int e = r / 704, p = r % 704, kt = 2 * ((p >> 1) / 22) + (p & 1), nt = (p >> 1) % 22; q = TrItem{a.w_gate + ((size_t)l * NE + e) * D * DFF, ws + WS_WGU + l * SZ_WGU + (size_t)e * 2816 * D * WEB, DFF, DFF, D, 64 * kt, 64 * nt, 2, WEB}; return; } r -= I_WG;
    if (r < I_WG) { const int e = r / 704, p = r % 704, kt = 2 * ((p >> 1) / 22) + (p & 1), nt = (p >> 1) % 22; q = TrItem{a.w_up + ((size_t)l * NE + e) * D * DFF, ws + WS_WGU + l * SZ_WGU + (size_t)e * 2816 * D * WEB, DFF, DFF, D, 64 * kt, 64 * nt, 3, WEB}; return; } r -= I_WG;
    { const int e = r / 704, p = r % 704, kt = 2 * ((p >> 1) / 32) + (p & 1), nt = (p >> 1) % 32; q = TrItem{a.w_down + ((size_t)l * NE + e) * DFF * D, ws + WS_WD + l * SZ_WD + (size_t)e * D * ACTP * WEB, D, D, ACTP, 64 * kt, 64 * nt, 1, WEB}; }
}
__device__ __forceinline__ int tr_row(int mode, int n) {
    if (mode == 0) return n < C_GK ? n : (n < C_GA ? (NWIN - 256) + (n - C_GK) : n - 16);
    if (mode == 2) return 256 * (n >> 7) + (n & 127);
    if (mode == 3) return 256 * (n >> 7) + 128 + (n & 127);
    return n; }
__device__ __forceinline__ void tr_load(const TrItem& q, f32x4 (&v)[16], int lane) {
    const int cc = 4 * (lane & 15), kq = lane >> 4;
#pragma unroll
    for (int i = 0; i < 16; ++i) { const int kk = 4 * i + kq; v[i] = (q.n0 + cc < q.N) ? __builtin_nontemporal_load((const f32x4*)(q.src + (size_t)(q.k0 + kk) * q.ldn + q.n0 + cc)) : (f32x4){0.f, 0.f, 0.f, 0.f}; }
}
__device__ __forceinline__ void tr_store(const TrItem& q, const f32x4 (&v)[16], LAS float* scr, int lane) {
    const int cc = 4 * (lane & 15), kq = lane >> 4;
#pragma unroll
    for (int i = 0; i < 16; ++i) { const int kk = 4 * i + kq; LAS float* s = scr + kk * 65 + cc; s[0] = v[i][0]; s[1] = v[i][1]; s[2] = v[i][2]; s[3] = v[i][3]; }
    asm volatile("s_waitcnt lgkmcnt(0)" ::: "memory");
    if (q.esz == 2) { const int c = lane & 7;
#pragma unroll
        for (int j = 0; j < 8; ++j) { const int nl = (lane >> 3) + 8 * j, n = q.n0 + nl; const LAS float* s = scr + (8 * c) * 65 + nl;
            u32x4 o; o.x = cvtpk(s[0 * 65], s[1 * 65]); o.y = cvtpk(s[2 * 65], s[3 * 65]); o.z = cvtpk(s[4 * 65], s[5 * 65]); o.w = cvtpk(s[6 * 65], s[7 * 65]);
            const int row = tr_row(q.mode, n);
            if (n < q.N) *(u32x4*)(q.dst + ((size_t)row * q.ldd + q.k0 + 8 * c) * 2) = o; } }
    else { const int c = lane & 3;
#pragma unroll
        for (int j = 0; j < 4; ++j) { const int nl = (lane >> 2) + 16 * j, n = q.n0 + nl; const LAS float* s = scr + (16 * c) * 65 + nl;
            u32x4 o; o.x = cvt4_f8(s[0 * 65] * F8_WGT, s[1 * 65] * F8_WGT, s[2 * 65] * F8_WGT, s[3 * 65] * F8_WGT); o.y = cvt4_f8(s[4 * 65] * F8_WGT, s[5 * 65] * F8_WGT, s[6 * 65] * F8_WGT, s[7 * 65] * F8_WGT);
            o.z = cvt4_f8(s[8 * 65] * F8_WGT, s[9 * 65] * F8_WGT, s[10 * 65] * F8_WGT, s[11 * 65] * F8_WGT); o.w = cvt4_f8(s[12 * 65] * F8_WGT, s[13 * 65] * F8_WGT, s[14 * 65] * F8_WGT, s[15 * 65] * F8_WGT);
            const int row = tr_row(q.mode, n);
            if (n < q.N) *(u32x4*)(q.dst + (size_t)row * q.ldd + q.k0 + 16 * c) = o; } }
    asm volatile("s_waitcnt lgkmcnt(0)" ::: "memory");
}
__device__ __forceinline__ void ph_prologue(const Args& a, LAS unsigned char* lds, int gw, int NGW, int wave, int lane) {
    LAS float* scr = (LAS float*)(lds + wave * 16640);
    constexpr int NT_IN = (NIN + 63) / 64;
    constexpr int I_LAYER = 32 * NT_IN + 8 * 32 + 32 * 32 + 32 * 32 + 2 * NE * 32 * 22 + NE * 22 * 32, NITEMS = 2 * I_LAYER;
    unsigned char* ws = a.ws;
    { TrItem qa, qb; f32x4 va[16], vb[16];
        for (int m = gw; m < BGP_A; m += NGW) {
            tr_decode(a, 2 * m, qa); tr_load(qa, va, lane); tr_decode(a, 2 * m + 1, qb); tr_load(qb, vb, lane);
            tr_store(qa, va, scr, lane); tr_store(qb, vb, scr, lane); } }
    const int gt = gw * 64 + lane, NGT = NGW * 64;
    for (int i = gt; i < 2 * 240 * (D * WEB_IN / 16); i += NGT) { const int l = i / (240 * (D * WEB_IN / 16)), q = i % (240 * (D * WEB_IN / 16)); *(u32x4*)(ws + WS_WIN + l * SZ_WIN + (size_t)(NWIN - 240) * D * WEB_IN + (size_t)q * 16) = (u32x4){0u, 0u, 0u, 0u}; }
    if (F8_MOE) {
        for (int i = gt; i < 2 * NE * D * 8; i += NGT) { const int pc = i & 7, row = (i >> 3) % (NE * D), l = (i >> 3) / (NE * D); *(u32x4*)(ws + WS_WD + l * SZ_WD + (size_t)row * ACTP + DFF + pc * 16) = (u32x4){0u, 0u, 0u, 0u}; } }
    for (int i = gt; i < (int)(MiB / 16); i += NGT) *(u32x4*)(ws + P_TOK + (size_t)i * 16) = (u32x4){0u, 0u, 0u, 0u};
    float* tab = (float*)(ws + WS_TAB);
    for (int i = gt; i < T * 16; i += NGT) { const int t = i >> 4, k = i & 15; const float inv = (float)pow(500000.0, -(double)(2 * k) / 32.0); const float ang = (float)a.pos[t] * inv;
        tab[i * 2] = (float)cos((double)ang); tab[i * 2 + 1] = (float)sin((double)ang); }
    if (F8_IN) { unsigned char* hq = ws + P_HB;
        for (int i = gt; i < T * D / 16; i += NGT) { const f32x4* xp = (const f32x4*)(a.x + (size_t)i * 16); const f32x4 p0 = __builtin_nontemporal_load(xp), p1 = __builtin_nontemporal_load(xp + 1), p2 = __builtin_nontemporal_load(xp + 2), p3 = __builtin_nontemporal_load(xp + 3);
            u32x4 o; o.x = cvt4_f8(p0[0] * F8_ACT, p0[1] * F8_ACT, p0[2] * F8_ACT, p0[3] * F8_ACT); o.y = cvt4_f8(p1[0] * F8_ACT, p1[1] * F8_ACT, p1[2] * F8_ACT, p1[3] * F8_ACT);
            o.z = cvt4_f8(p2[0] * F8_ACT, p2[1] * F8_ACT, p2[2] * F8_ACT, p2[3] * F8_ACT); o.w = cvt4_f8(p3[0] * F8_ACT, p3[1] * F8_ACT, p3[2] * F8_ACT, p3[3] * F8_ACT); *(u32x4*)(hq + (size_t)i * 16) = o; } }
    else { u16* hb = (u16*)(ws + P_HB);
        for (int i = gt; i < T * D / 8; i += NGT) { const f32x4 p = *(const f32x4*)(a.x + (size_t)i * 8), q = *(const f32x4*)(a.x + (size_t)i * 8 + 4);
            u32x4 o; o.x = cvtpk(p[0], p[1]); o.y = cvtpk(p[2], p[3]); o.z = cvtpk(q[0], q[1]); o.w = cvtpk(q[2], q[3]); *(u32x4*)(hb + (size_t)i * 8) = o; } }
}

__device__ __forceinline__ void ph_bgconv(const Args& a, LAS unsigned char* lds, int lo, int hi, int cw, int NCW, int wave, int lane) {
    LAS float* scr = (LAS float*)(lds + wave * 16640);
    const int npw = (hi - lo - cw + NCW - 1) / NCW, nts = npw > 0 ? 2 * npw : 0;
    TrItem qa, qb, qc; f32x4 va[16], vb[16], vc[16];
    for (int sidx = 0; sidx < nts; sidx += 3) {
        tr_decode(a, 2 * (lo + cw + (sidx >> 1) * NCW) + (sidx & 1), qa); tr_load(qa, va, lane);
        if (sidx + 1 < nts) { tr_decode(a, 2 * (lo + cw + ((sidx + 1) >> 1) * NCW) + ((sidx + 1) & 1), qb); tr_load(qb, vb, lane); }
        if (sidx + 2 < nts) { tr_decode(a, 2 * (lo + cw + ((sidx + 2) >> 1) * NCW) + ((sidx + 2) & 1), qc); tr_load(qc, vc, lane); }
        tr_store(qa, va, scr, lane);
        if (sidx + 1 < nts) tr_store(qb, vb, scr, lane);
        if (sidx + 2 < nts) tr_store(qc, vc, scr, lane); }
}

__device__ __forceinline__ void ph_attn_simple(const u16* Qa, const u16* Ka, const u16* Va, u16* Oa, float* LSE, LAS unsigned char* lds, int gw, int NGW, int wave, int lane) {
    LAS float* sq = (LAS float*)(lds + wave * 2048); LAS float* sp = sq + 128;
    for (int item = gw; item < T * 12; item += NGW) {
        const int t = item / 12, head = item % 12, g = head >> 2, hh = head & 3, dil = g == 0 ? 1 : (g == 1 ? 4 : 16), b = t / SEQ, s = t % SEQ;
        const u16* q = Qa + (size_t)t * 1536 + head * 128;
        asm volatile("s_waitcnt lgkmcnt(0)" ::: "memory");
        sq[lane] = bf2f(q[lane]); sq[lane + 64] = bf2f(q[lane + 64]);
        asm volatile("s_waitcnt lgkmcnt(0)" ::: "memory");
        float sc[3]; float m = -INFINITY;
#pragma unroll
        for (int r = 0; r < 3; ++r) { const int j = lane + 64 * r; sc[r] = -INFINITY;
            if (j <= 128) { const int sk = s - j * dil;
                if (sk >= 0) { const uint4* k = (const uint4*)(Ka + (size_t)(b * SEQ + sk) * 1536 + head * 128); float a = 0.f;
                    for (int d8 = 0; d8 < 16; ++d8) { const uint4 kv = k[d8]; const unsigned ww[4] = {kv.x, kv.y, kv.z, kv.w};
#pragma unroll
                        for (int x = 0; x < 4; ++x) { a += sq[d8 * 8 + 2 * x] * bflo(ww[x]); a += sq[d8 * 8 + 2 * x + 1] * bfhi(ww[x]); } }
                    sc[r] = a; } }
            m = fmaxf(m, sc[r]); }
        m = wave_max(m);
        float den = 0.f;
#pragma unroll
        for (int r = 0; r < 3; ++r) { const int j = lane + 64 * r; const float pe = (sc[r] == -INFINITY) ? 0.f : expf(sc[r] - m); den += pe; if (j <= 128) sp[j] = pe; }
        den = wave_sum(den);
        asm volatile("s_waitcnt lgkmcnt(0)" ::: "memory");
        float o0 = 0.f, o1 = 0.f;
        for (int j = 0; j <= 128; ++j) { const int sk = s - j * dil; if (sk < 0) break; const float pj = sp[j];
            const u16* v = Va + (size_t)(b * SEQ + sk) * 1536 + head * 128; o0 += pj * bf2f(v[lane]); o1 += pj * bf2f(v[lane + 64]); }
        const float inv = 1.f / den;
        u16* o = Oa + ((size_t)g * T + t) * 512 + hh * 128; o[lane] = f2bf(o0 * inv); o[lane + 64] = f2bf(o1 * inv);
        if (lane == 0) LSE[((size_t)g * T + t) * 4 + hh] = m + logf(den);
    }
}
__device__ __forceinline__ void ph_ya(const u16* __restrict__ Oa, const float* __restrict__ LSE, u16* __restrict__ ya, int gt, int NGT) {
    for (int idx = gt; idx < T * 64; idx += NGT) { const int t = idx >> 6, c = (idx & 63) * 8, hh = c >> 7;
        const float l0 = LSE[((size_t)0 * T + t) * 4 + hh], l1 = LSE[((size_t)1 * T + t) * 4 + hh], l2 = LSE[((size_t)2 * T + t) * 4 + hh];
        const float mx = fmaxf(l0, fmaxf(l1, l2)); float e0 = __expf(l0 - mx), e1 = __expf(l1 - mx), e2 = __expf(l2 - mx); const float inv = 1.f / (e0 + e1 + e2); e0 *= inv; e1 *= inv; e2 *= inv;
        const u32x4 a0 = *(const u32x4*)(Oa + ((size_t)0 * T + t) * 512 + c), a1 = *(const u32x4*)(Oa + ((size_t)1 * T + t) * 512 + c), a2 = *(const u32x4*)(Oa + ((size_t)2 * T + t) * 512 + c);
        const float o0 = e0 * bflo(a0.x) + e1 * bflo(a1.x) + e2 * bflo(a2.x), o1 = e0 * bfhi(a0.x) + e1 * bfhi(a1.x) + e2 * bfhi(a2.x), o2 = e0 * bflo(a0.y) + e1 * bflo(a1.y) + e2 * bflo(a2.y), o3 = e0 * bfhi(a0.y) + e1 * bfhi(a1.y) + e2 * bfhi(a2.y);
        const float o4 = e0 * bflo(a0.z) + e1 * bflo(a1.z) + e2 * bflo(a2.z), o5 = e0 * bfhi(a0.z) + e1 * bfhi(a1.z) + e2 * bfhi(a2.z), o6 = e0 * bflo(a0.w) + e1 * bflo(a1.w) + e2 * bflo(a2.w), o7 = e0 * bfhi(a0.w) + e1 * bfhi(a1.w) + e2 * bfhi(a2.w);
        if (F8_MRG) { u32x2 w8; w8.x = cvt4_f8(o0 * F8_ACT, o1 * F8_ACT, o2 * F8_ACT, o3 * F8_ACT); w8.y = cvt4_f8(o4 * F8_ACT, o5 * F8_ACT, o6 * F8_ACT, o7 * F8_ACT); *(u32x2*)((unsigned char*)ya + (size_t)t * KAB + c) = w8; }
        else { u32x4 w; w.x = cvtpk(o0, o1); w.y = cvtpk(o2, o3); w.z = cvtpk(o4, o5); w.w = cvtpk(o6, o7); *(u32x4*)(ya + (size_t)t * KAB + c) = w; } }
}
typedef short v4i16_t __attribute__((ext_vector_type(4)));
__device__ __forceinline__ void ph_attn(const u16* __restrict__ Qa, const u16* __restrict__ Ka, const u16* __restrict__ Va, u16* __restrict__ Oa, float* __restrict__ LSE, LAS unsigned char* lds, int bx, int G, int wv) {
    int tid = WV_TID(wv); asm volatile("" : "+v"(tid));
    const int wid = __builtin_amdgcn_readfirstlane(tid >> 6), lane = tid & 63, i16 = lane & 15, g4 = lane >> 4;
    constexpr int RS = 272, VOFF = 256 * RS;
    const int kt0 = wid < 6 ? wid : 6;
    const int pc = tid & 15, row0 = tid >> 4;
    u32x4 kreg[8], vreg[8]; bf16x8 qn[4];
#define AT_DECODE(u0_) const int u = pg8::xcd_remap((u0_), 768);   \
        const int bh = u >> 5, sub = u & 31, b = bh / 12, head = bh - 12 * b, grp = head >> 2, hh = head & 3; \
        const int dsh = 2 * grp, dil = 1 << dsh, nb = 32 >> dsh, r = sub / nb, bq = sub - r * nb;       \
        const int qq = 16 * wid + i16; const size_t tq = (size_t)b * SEQ + (size_t)(128 * bq + qq) * dil + r
#define AT_REQUEST() do { _Pragma("unroll") for (int j = 0; j < 8; ++j) { const int c = row0 + 32 * j, l = 128 * (bq - 1) + c; \
            if (l >= 0) { const size_t off = ((size_t)b * SEQ + (size_t)l * dil + r) * 1536 + head * 128 + pc * 8; kreg[j] = *(const u32x4*)(Ka + off); vreg[j] = *(const u32x4*)(Va + off); } \
            else { kreg[j] = (u32x4){0u, 0u, 0u, 0u}; vreg[j] = (u32x4){0u, 0u, 0u, 0u}; } } \
        _Pragma("unroll") for (int ks = 0; ks < 4; ++ks) qn[ks] = *(const bf16x8*)(Qa + tq * 1536 + head * 128 + 32 * ks + 8 * g4); } while (0)
    if (bx < 768) { AT_DECODE(bx); AT_REQUEST(); (void)grp; (void)hh; (void)qq; }
    for (int u0 = bx; u0 < 768; u0 += G) {
        AT_DECODE(u0);
        bf16x8 qf[4];
#pragma unroll
        for (int ks = 0; ks < 4; ++ks) qf[ks] = qn[ks];
#pragma unroll
        for (int j = 0; j < 8; ++j) { const int c = row0 + 32 * j; *(LAS u32x4*)(lds + c * RS + pc * 16) = kreg[j]; *(LAS u32x4*)(lds + VOFF + c * RS + pc * 16) = vreg[j]; }
        __syncthreads();
        if (u0 + G < 768) { int un = u0 + G; asm volatile("" : "+s"(un)); { AT_DECODE(un); AT_REQUEST(); (void)grp; (void)hh; (void)qq; } asm volatile("" ::: "memory"); }
        f32x4 sc[10];
#pragma unroll
        for (int kk = 0; kk < 10; ++kk) { sc[kk] = (f32x4){0.f, 0.f, 0.f, 0.f};
#pragma unroll
            for (int ks = 0; ks < 4; ++ks) { const bf16x8 kf = *(const LAS bf16x8*)(lds + (16 * (kt0 + kk) + i16) * RS + (32 * ks + 8 * g4) * 2);
                sc[kk] = __builtin_amdgcn_mfma_f32_16x16x32_bf16(kf, qf[ks], sc[kk], 0, 0, 0); } }
        float m = -INFINITY;
#pragma unroll
        for (int kk = 0; kk < 10; ++kk)
#pragma unroll
            for (int rr = 0; rr < 4; ++rr) { const int c = 16 * (kt0 + kk) + 4 * g4 + rr; const bool ok = (c >= qq) && (c <= qq + 128) && (bq > 0 || c >= 128);
                sc[kk][rr] = ok ? sc[kk][rr] : -INFINITY; m = fmaxf(m, sc[kk][rr]); }
        m = fmaxf(m, __shfl_xor(m, 16)); m = fmaxf(m, __shfl_xor(m, 32));
        float den = 0.f;
#pragma unroll
        for (int kk = 0; kk < 10; ++kk)
#pragma unroll
            for (int rr = 0; rr < 4; ++rr) { const float p = exp2f((sc[kk][rr] - m) * 1.4426950408889634f); sc[kk][rr] = p; den += p; }
        den += __shfl_xor(den, 16); den += __shfl_xor(den, 32);
        f32x4 o[8];
#pragma unroll
        for (int dt = 0; dt < 8; ++dt) o[dt] = (f32x4){0.f, 0.f, 0.f, 0.f};
        const int q4 = i16 >> 2, p4 = i16 & 3;
#pragma unroll
        for (int pr = 0; pr < 5; ++pr) {
            u32x4 pw; pw.x = cvtpk(sc[2 * pr][0], sc[2 * pr][1]); pw.y = cvtpk(sc[2 * pr][2], sc[2 * pr][3]); pw.z = cvtpk(sc[2 * pr + 1][0], sc[2 * pr + 1][1]); pw.w = cvtpk(sc[2 * pr + 1][2], sc[2 * pr + 1][3]);
            const bf16x8 pf = __builtin_bit_cast(bf16x8, pw);
            const int rlo = 16 * (kt0 + 2 * pr) + 4 * g4 + q4, rhi = rlo + 16;
#pragma unroll
            for (int dt = 0; dt < 8; ++dt) {
                const v4i16_t lo = __builtin_amdgcn_ds_read_tr16_b64_v4i16((LAS v4i16_t*)(lds + VOFF + rlo * RS + (16 * dt + 4 * p4) * 2));
                const v4i16_t hi = __builtin_amdgcn_ds_read_tr16_b64_v4i16((LAS v4i16_t*)(lds + VOFF + rhi * RS + (16 * dt + 4 * p4) * 2));
                const bf16x8 vf = (bf16x8){lo[0], lo[1], lo[2], lo[3], hi[0], hi[1], hi[2], hi[3]};
                o[dt] = __builtin_amdgcn_mfma_f32_16x16x32_bf16(vf, pf, o[dt], 0, 0, 0); } }
        const float inv = 1.f / den;
        u16* op = Oa + ((size_t)grp * T + tq) * 512 + hh * 128 + 4 * g4;
#pragma unroll
        for (int dt = 0; dt < 8; ++dt) { u32x2 w; w.x = cvtpk(o[dt][0] * inv, o[dt][1] * inv); w.y = cvtpk(o[dt][2] * inv, o[dt][3] * inv); *(u32x2*)(op + 16 * dt) = w; }
        if (g4 == 0) LSE[((size_t)grp * T + tq) * 4 + hh] = m + logf(den);
        __syncthreads();
    }
#undef AT_DECODE
#undef AT_REQUEST
}
constexpr int GP_QL = 0, GP_KL = 33792, GP_GK = 67584, GP_TOT = 71680, GP_VL = 73728, GP_ROW = 528, GP_VROW = 1040;
__device__ __forceinline__ void ph_gla_prep(const u16* __restrict__ Qb, const u16* __restrict__ Kb, const u16* __restrict__ Vb, const float* __restrict__ gkl, const float* __restrict__ wgk2, const float* __restrict__ bgk,
                                            u16* __restrict__ QT, u16* __restrict__ KDT, u16* __restrict__ VT, u16* __restrict__ ATT, float* __restrict__ DEC, LAS unsigned char* lds, int bx, int G, int wv) {
    int tid = WV_TID(wv); asm volatile("" : "+v"(tid));
    const int wid = __builtin_amdgcn_readfirstlane(tid >> 6), lane = tid & 63, i16 = lane & 15, g4 = lane >> 4, ch = tid & 255, half = tid >> 8;
    for (int u = bx; u < 512; u += G) {
        const int n = u & 63, bh = u >> 6, h = bh & 3, b = bh >> 2; const size_t t0 = (size_t)b * SEQ + 64 * n;
        if (tid < 256) *(LAS f32x4*)(lds + GP_GK + tid * 16) = *(const f32x4*)(gkl + t0 * 16 + tid * 4);
#pragma unroll
        for (int j = 0; j < 8; ++j) { const int row = (tid >> 6) + 8 * j, pc = tid & 63; *(LAS u32x4*)(lds + GP_VL + row * GP_VROW + pc * 16) = *(const u32x4*)(Vb + (t0 + row) * 2048 + h * 512 + pc * 8); }
#pragma unroll
        for (int j = 0; j < 4; ++j) { const int row = (tid >> 5) + 16 * j, pc = tid & 31; const size_t go = (t0 + row) * 1024 + h * 256 + pc * 8;
            *(LAS u32x4*)(lds + GP_QL + row * GP_ROW + pc * 16) = *(const u32x4*)(Qb + go); *(LAS u32x4*)(lds + GP_KL + row * GP_ROW + pc * 16) = *(const u32x4*)(Kb + go); }
        float wk[16];
#pragma unroll
        for (int j = 0; j < 16; ++j) wk[j] = wgk2[j * 1024 + h * 256 + ch];
        const float bk = bgk[h * 256 + ch];
        __syncthreads();
        float bl[32]; float run = 0.f;
#pragma unroll
        for (int i = 0; i < 32; ++i) { const LAS f32x4* gp = (const LAS f32x4*)(lds + GP_GK + (half * 32 + i) * 64); float gk = bk;
#pragma unroll
            for (int j4 = 0; j4 < 4; ++j4) { const f32x4 gv = gp[j4]; gk += gv[0] * wk[4 * j4] + gv[1] * wk[4 * j4 + 1] + gv[2] * wk[4 * j4 + 2] + gv[3] * wk[4 * j4 + 3]; }
            const float ls = fminf(gk, 0.f) - __logf(1.f + __expf(-fabsf(gk))); run += ls * (1.f / 16.f); bl[i] = run; }
        *(LAS float*)(lds + GP_TOT + (half * 256 + ch) * 4) = run;
#pragma unroll
        for (int j = 0; j < 8; ++j) { const int p = tid + 512 * j, v = p >> 3, c8 = p & 7; unsigned w[4];
#pragma unroll
            for (int q = 0; q < 4; ++q) { const unsigned lo = *(const LAS u16*)(lds + GP_VL + (8 * c8 + 2 * q) * GP_VROW + v * 2), hi = *(const LAS u16*)(lds + GP_VL + (8 * c8 + 2 * q + 1) * GP_VROW + v * 2); w[q] = lo | (hi << 16); }
            *(u32x4*)(VT + ((size_t)u * 512 + v) * 64 + 8 * c8) = (u32x4){w[0], w[1], w[2], w[3]}; }
        __syncthreads();
        const float tot0 = *(const LAS float*)(lds + GP_TOT + ch * 4), tot1 = *(const LAS float*)(lds + GP_TOT + (256 + ch) * 4); const float blast = tot0 + tot1, boff = half ? tot0 : 0.f;
        unsigned kd[16];
#pragma unroll
        for (int i = 0; i < 32; ++i) { const int c = half * 32 + i; const float bb = bl[i] + boff;
            LAS u16* qlp = (LAS u16*)(lds + GP_QL + c * GP_ROW + ch * 2); LAS u16* klp = (LAS u16*)(lds + GP_KL + c * GP_ROW + ch * 2);
            const float q = bf2f(*qlp), k = bf2f(*klp);
            const float eb = __expf(bb), qt = q * 0.0625f * eb, kt = k * __builtin_amdgcn_rcpf(eb), kdv = k * __expf(blast - bb);
            *qlp = f2bf(qt); *klp = f2bf(kt);
            if (i & 1) kd[i >> 1] |= (unsigned)f2bf(kdv) << 16; else kd[i >> 1] = (unsigned)f2bf(kdv); }
        { u16* kp = KDT + ((size_t)u * 256 + ch) * 64 + half * 32;
#pragma unroll
            for (int q = 0; q < 4; ++q) *(u32x4*)(kp + 8 * q) = (u32x4){kd[4 * q], kd[4 * q + 1], kd[4 * q + 2], kd[4 * q + 3]}; }
        if (half == 0) DEC[(size_t)u * 256 + ch] = __expf(blast);
        __syncthreads();
#pragma unroll
        for (int j = 0; j < 4; ++j) { const int row = (tid >> 5) + 16 * j, pc = tid & 31; *(u32x4*)(QT + (t0 + row) * 1024 + h * 256 + pc * 8) = *(const LAS u32x4*)(lds + GP_QL + row * GP_ROW + pc * 16); }
#pragma unroll
        for (int tt = 0; tt < 2; ++tt) { const int id = 2 * wid + tt, st = id >> 2, ct = id & 3; f32x4 acc = (f32x4){0.f, 0.f, 0.f, 0.f};
            if (st <= ct) {
#pragma unroll
                for (int kk = 0; kk < 8; ++kk) { const bf16x8 af = *(const LAS bf16x8*)(lds + GP_KL + (16 * st + i16) * GP_ROW + (32 * kk + 8 * g4) * 2), bf = *(const LAS bf16x8*)(lds + GP_QL + (16 * ct + i16) * GP_ROW + (32 * kk + 8 * g4) * 2);
                    acc = __builtin_amdgcn_mfma_f32_16x16x32_bf16(af, bf, acc, 0, 0, 0); } }
            const int c = 16 * ct + i16, s0 = 16 * st + 4 * g4;
#pragma unroll
            for (int r = 0; r < 4; ++r) acc[r] = (s0 + r <= c) ? acc[r] : 0.f;
            u32x2 w; w.x = cvtpk(acc[0], acc[1]); w.y = cvtpk(acc[2], acc[3]); *(u32x2*)(ATT + (size_t)u * 4096 + c * 64 + s0) = w; }
        __syncthreads();
    }
}
constexpr int GS_SLOT = 16640, GS_B = 8192, GS_D = 16384;
template <int N> __device__ __forceinline__ void gs_wait() { asm volatile("s_waitcnt vmcnt(%0)" :: "n"(N) : "memory"); }
__device__ __forceinline__ void gs_wait_n(int n) { switch (n) { case 0: gs_wait<18>(); break; case 1: gs_wait<19>(); break; case 2: gs_wait<20>(); break; case 3: gs_wait<21>(); break; case 4: gs_wait<22>(); break; case 5: gs_wait<23>(); break; default: gs_wait<24>(); break; } }
template <bool DOSTORE = true>
__device__ __forceinline__ void ph_gla_scan(const u16* __restrict__ KDT, const u16* __restrict__ VT, const float* __restrict__ DEC, u16* __restrict__ SN, LAS unsigned char* lds, int bx, int G, int wv) {
    int tid = WV_TID(wv); asm volatile("" : "+v"(tid));
    const int wid = __builtin_amdgcn_readfirstlane(tid >> 6), lane = tid & 63, i16 = lane & 15, g4 = lane >> 4;
    for (int it0 = bx; it0 < 256; it0 += G) {
        const int it = (G & 7) == 0 ? ((it0 & 7) << 5) | ((it0 >> 3) & 31) : it0;
        const int vb = it & 7, kb = (it >> 3) & 3, bh = it >> 5;
        const int kp = wid >> 2, kc = kb * 2 + kp, v0 = vb * 64 + 16 * (wid & 3);
        const int lr = 8 * wid + (lane >> 3), lp = lane & 7;
        const int fa = ((lr >> 1) & 1) | (((lr >> 3) & 3) << 1), fb = (lr >> 1) & 7;
        const unsigned ga_off = (unsigned)((kb * 64 + lr) * 128 + ((lp ^ fa) << 4)), gb_off = (unsigned)((vb * 64 + lr) * 128 + ((lp ^ fb) << 4));
        const char* kdt_b = (const char*)KDT + (size_t)bh * 64 * 256 * 128; const char* vt_b = (const char*)VT + (size_t)bh * 64 * 512 * 128; const char* dec_b = (const char*)DEC + (size_t)bh * 64 * 1024 + kb * 256 + lane * 4;
#define GS_ISSUE(n_) do { const int nn_ = (n_) < 64 ? (n_) : 63; LAS unsigned char* sl_ = lds + ((n_) & 7) * GS_SLOT; \
        __builtin_amdgcn_global_load_lds((const unsigned*)(kdt_b + (size_t)nn_ * 256 * 128 + ga_off), (LAS unsigned*)(sl_ + wid * 1024), 16, 0, 0); \
        __builtin_amdgcn_global_load_lds((const unsigned*)(vt_b + (size_t)nn_ * 512 * 128 + gb_off), (LAS unsigned*)(sl_ + GS_B + wid * 1024), 16, 0, 0); \
        __builtin_amdgcn_global_load_lds((const unsigned*)(dec_b + (size_t)nn_ * 1024), (LAS unsigned*)(sl_ + GS_D), 4, 0, 0); } while (0)
        const int ar0 = 32 * kp + 8 * (i16 >> 2) + (i16 & 3), ar1 = ar0 + 4, br = 16 * (wid & 3) + i16;
        const int fa0 = ((ar0 >> 1) & 1) | (((ar0 >> 3) & 3) << 1), fa1 = ((ar1 >> 1) & 1) | (((ar1 >> 3) & 3) << 1), fbr = (br >> 1) & 7;
        const int oa00 = ar0 * 128 + ((g4 ^ fa0) << 4), oa01 = ar0 * 128 + (((4 + g4) ^ fa0) << 4), oa10 = ar1 * 128 + ((g4 ^ fa1) << 4), oa11 = ar1 * 128 + (((4 + g4) ^ fa1) << 4);
        const int ob0 = GS_B + br * 128 + ((g4 ^ fbr) << 4), ob1 = GS_B + br * 128 + (((4 + g4) ^ fbr) << 4), od = GS_D + (32 * kp + 8 * g4) * 4;
        f32x4 S0 = (f32x4){0.f, 0.f, 0.f, 0.f}, S1 = S0;
        GS_ISSUE(0); GS_ISSUE(1); GS_ISSUE(2); GS_ISSUE(3); GS_ISSUE(4); GS_ISSUE(5); GS_ISSUE(6);
#define GS_STEP(n_) do { \
        if (__builtin_constant_p(n_) && (n_) < 7) gs_wait_n((n_)); else gs_wait<25>();                            \
        __builtin_amdgcn_s_barrier();                                      \
        GS_ISSUE((n_) + 7);                                                \
        const LAS unsigned char* sl = lds + ((n_) & 7) * GS_SLOT; \
        const bf16x8 a00 = *(const LAS bf16x8*)(sl + oa00), a01 = *(const LAS bf16x8*)(sl + oa01), a10 = *(const LAS bf16x8*)(sl + oa10), a11 = *(const LAS bf16x8*)(sl + oa11); \
        const bf16x8 b0 = *(const LAS bf16x8*)(sl + ob0), b1 = *(const LAS bf16x8*)(sl + ob1); const f32x4 d0 = *(const LAS f32x4*)(sl + od), d1 = *(const LAS f32x4*)(sl + od + 16); \
        const size_t u = (size_t)bh * 64 + (n_); \
        u32x4 w; w.x = cvtpk(S0[0], S0[1]); w.y = cvtpk(S0[2], S0[3]); w.z = cvtpk(S1[0], S1[1]); w.w = cvtpk(S1[2], S1[3]); \
        if (!DOSTORE) asm volatile("" :: "v"(w)); \
        else if (SN_F8) { u32x2 w8; w8.x = cvt4_f8(S0[0], S0[1], S0[2], S0[3]); w8.y = cvt4_f8(S1[0], S1[1], S1[2], S1[3]); *(u32x2*)((unsigned char*)SN + ((u * 8 + kc) * 512 + v0 + i16) * 32 + 8 * g4) = w8; } \
        else *(u32x4*)(SN + ((u * 8 + kc) * 512 + v0 + i16) * 32 + 8 * g4) = w; \
        S0 = S0 * d0; S1 = S1 * d1; \
        S0 = __builtin_amdgcn_mfma_f32_16x16x32_bf16(a00, b0, S0, 0, 0, 0); S0 = __builtin_amdgcn_mfma_f32_16x16x32_bf16(a01, b1, S0, 0, 0, 0); \
        S1 = __builtin_amdgcn_mfma_f32_16x16x32_bf16(a10, b0, S1, 0, 0, 0); S1 = __builtin_amdgcn_mfma_f32_16x16x32_bf16(a11, b1, S1, 0, 0, 0); } while (0)
#define GS_STEP8(n_) GS_STEP(n_); GS_STEP((n_) + 1); GS_STEP((n_) + 2); GS_STEP((n_) + 3); GS_STEP((n_) + 4); GS_STEP((n_) + 5); GS_STEP((n_) + 6); GS_STEP((n_) + 7)
        GS_STEP8(0);
        for (int nb = 8; nb < 64; nb += 8) { GS_STEP8(nb); }
#undef GS_STEP8
#undef GS_STEP
#undef GS_ISSUE
        asm volatile("s_waitcnt vmcnt(0)" ::: "memory"); __syncthreads();
    }
}
template <int MODE = 0>
__device__ __forceinline__ void ph_gla_out(const u16* __restrict__ SN, const u16* __restrict__ QT, const u16* __restrict__ VT, const u16* __restrict__ ATT, const float* __restrict__ gg, const u16* __restrict__ Rb, u16* __restrict__ yab, LAS unsigned char* lds, int bx, int G, int wv) {
    int tid = WV_TID(wv); asm volatile("" : "+v"(tid));
    const int wid = __builtin_amdgcn_readfirstlane(tid >> 6), lane = tid & 63, i16 = lane & 15, g4 = lane >> 4;
    LAS float* part = (LAS float*)lds;
    for (int u = bx; u < 512; u += G) {
        const int n = u & 63, bh = u >> 6, h = bh & 3, b = bh >> 2; const size_t t0 = (size_t)b * SEQ + 64 * n;
        f32x4 acc[4][4];
#pragma unroll
        for (int vt = 0; vt < 4; ++vt)
#pragma unroll
            for (int ct = 0; ct < 4; ++ct) acc[vt][ct] = (f32x4){0.f, 0.f, 0.f, 0.f};
        const u16* sp = SN + ((size_t)u * 8 * 512 + 64 * wid + i16) * 32 + 8 * g4; const u16* qp = QT + (t0 + i16) * 1024 + h * 256 + 8 * g4;
        const u16* vp = VT + ((size_t)u * 512 + 64 * wid + i16) * 64 + 8 * g4; const u16* ap = ATT + (size_t)u * 4096 + i16 * 64 + 8 * g4;
        bf16x8 af[2][4], bf[2][4];
#define GO_LOAD(buf_, j_) do { if ((j_) < 8) { _Pragma("unroll") for (int x = 0; x < 4; ++x) { af[buf_][x] = SN_F8 ? ld_f8x8((const unsigned char*)SN + (((size_t)u * 8 + (j_)) * 512 + 64 * wid + x * 16 + i16) * 32 + 8 * g4) : *(const bf16x8*)(sp + ((size_t)(j_) * 512 + x * 16) * 32); bf[buf_][x] = *(const bf16x8*)(qp + (size_t)x * 16 * 1024 + 32 * (j_)); } } \
        else { _Pragma("unroll") for (int x = 0; x < 4; ++x) { af[buf_][x] = *(const bf16x8*)(vp + (size_t)x * 16 * 64 + 32 * ((j_) - 8)); bf[buf_][x] = *(const bf16x8*)(ap + (size_t)x * 16 * 64 + 32 * ((j_) - 8)); } } } while (0)
#define GO_MMA(buf_) do { _Pragma("unroll") for (int vt = 0; vt < 4; ++vt) _Pragma("unroll") for (int ct = 0; ct < 4; ++ct) acc[vt][ct] = __builtin_amdgcn_mfma_f32_16x16x32_bf16(af[buf_][vt], bf[buf_][ct], acc[vt][ct], 0, 0, 0); } while (0)
        if (MODE != 2) {
        GO_LOAD(0, 0); GO_LOAD(1, 1);
        GO_MMA(0); GO_LOAD(0, 2); GO_MMA(1); GO_LOAD(1, 3); GO_MMA(0); GO_LOAD(0, 4); GO_MMA(1); GO_LOAD(1, 5);
        GO_MMA(0); GO_LOAD(0, 6); GO_MMA(1); GO_LOAD(1, 7); GO_MMA(0); GO_LOAD(0, 8); GO_MMA(1); GO_LOAD(1, 9); GO_MMA(0); GO_MMA(1);
        }
#undef GO_LOAD
#undef GO_MMA
        if (MODE == 1) { _Pragma("unroll") for (int vt = 0; vt < 4; ++vt) _Pragma("unroll") for (int ct = 0; ct < 4; ++ct) asm volatile("" :: "v"(acc[vt][ct])); continue; }
#pragma unroll
        for (int ct = 0; ct < 4; ++ct) { float ss = 0.f;
#pragma unroll
            for (int vt = 0; vt < 4; ++vt) ss += (acc[vt][ct][0] * acc[vt][ct][0] + acc[vt][ct][1] * acc[vt][ct][1]) + (acc[vt][ct][2] * acc[vt][ct][2] + acc[vt][ct][3] * acc[vt][ct][3]);
            ss += __shfl_xor(ss, 16); ss += __shfl_xor(ss, 32);
            if (g4 == 0) part[wid * 64 + 16 * ct + i16] = ss; }
        __syncthreads();
        constexpr int OT = 4096, OROW = 1040;
#pragma unroll
        for (int ct = 0; ct < 4; ++ct) { float tot = 0.f;
#pragma unroll
            for (int w = 0; w < 8; ++w) tot += part[w * 64 + 16 * ct + i16];
            const float rstd = rsqrtf(tot * (1.f / 512.f) + 1e-6f);
#pragma unroll
            for (int vt = 0; vt < 4; ++vt) { const int v = 64 * wid + 16 * vt + 4 * g4; const f32x4 gv = *(const f32x4*)(gg + v); const f32x4 o = acc[vt][ct] * rstd * gv;
                u32x2 w; w.x = cvtpk(o[0], o[1]); w.y = cvtpk(o[2], o[3]); *(LAS u32x2*)(lds + OT + (16 * ct + i16) * OROW + v * 2) = w; } }
        __syncthreads();
#pragma unroll
        for (int j = 0; j < 8; ++j) { const int p = tid + 512 * j, c = p >> 6, v8 = (p & 63) * 8; const size_t t = t0 + c;
            const u32x4 ov = *(const LAS u32x4*)(lds + OT + c * OROW + v8 * 2), rb = *(const u32x4*)(Rb + t * 2048 + h * 512 + v8);
            if (F8_MRG) { u32x2 w8; w8.x = cvt4_f8(bflo(ov.x) * bflo(rb.x) * F8_ACT, bfhi(ov.x) * bfhi(rb.x) * F8_ACT, bflo(ov.y) * bflo(rb.y) * F8_ACT, bfhi(ov.y) * bfhi(rb.y) * F8_ACT);
                w8.y = cvt4_f8(bflo(ov.z) * bflo(rb.z) * F8_ACT, bfhi(ov.z) * bfhi(rb.z) * F8_ACT, bflo(ov.w) * bflo(rb.w) * F8_ACT, bfhi(ov.w) * bfhi(rb.w) * F8_ACT);
                if (MODE != 2) *(u32x2*)((unsigned char*)yab + t * KAB + 512 + h * 512 + v8) = w8; else asm volatile("" :: "v"(w8)); }
            else { u32x4 w; w.x = cvtpk(bflo(ov.x) * bflo(rb.x), bfhi(ov.x) * bfhi(rb.x)); w.y = cvtpk(bflo(ov.y) * bflo(rb.y), bfhi(ov.y) * bfhi(rb.y));
                w.z = cvtpk(bflo(ov.z) * bflo(rb.z), bfhi(ov.z) * bfhi(rb.z)); w.w = cvtpk(bflo(ov.w) * bflo(rb.w), bfhi(ov.w) * bfhi(rb.w));
                if (MODE != 2) *(u32x4*)(yab + t * KAB + 512 + h * 512 + v8) = w; else asm volatile("" :: "v"(w)); } }
        __syncthreads();
    }
}
__device__ __forceinline__ void ph_gla_simple(const u16* Qb, const u16* Kb, const u16* Vb, const float* gkl, const float* wgk2, const float* bgk, float* Ob, LAS unsigned char* lds) {
    if (blockIdx.x >= 64) return;
    LAS float* sa = (LAS float*)lds; LAS float* sk = sa + 8 * 256; LAS float* sqv = sk + 8 * 256; LAS float* sv = sqv + 8 * 256; LAS float* part = sv + 8 * 64;
    int tid = threadIdx.x; asm volatile("" : "+v"(tid));
    const int blk = blockIdx.x, vs = blk & 7, h = (blk >> 3) & 3, b = blk >> 5, v = tid & 63, kg = tid >> 6, ch = tid & 255, ih = tid >> 8;
    float S[32];
#pragma unroll
    for (int i = 0; i < 32; ++i) S[i] = 0.f;
    float wk[16];
#pragma unroll
    for (int j = 0; j < 16; ++j) wk[j] = wgk2[j * 1024 + h * 256 + ch];
    const float bk = bgk[h * 256 + ch];
    for (int t0 = 0; t0 < SEQ; t0 += 8) {
        for (int ii = 0; ii < 4; ++ii) { const int i = ih * 4 + ii; const size_t t = (size_t)b * SEQ + t0 + i; float gk = bk;
#pragma unroll
            for (int j = 0; j < 16; ++j) gk += gkl[t * 16 + j] * wk[j];
            const float ls = fminf(gk, 0.f) - log1pf(expf(-fabsf(gk)));
            sa[i * 256 + ch] = expf(ls * (1.f / 16.f)); sk[i * 256 + ch] = bf2f(Kb[t * 1024 + h * 256 + ch]); sqv[i * 256 + ch] = bf2f(Qb[t * 1024 + h * 256 + ch]) * 0.0625f; }
        { const int i = tid >> 6, vv = tid & 63; sv[i * 64 + vv] = bf2f(Vb[((size_t)b * SEQ + t0 + i) * 2048 + h * 512 + vs * 64 + vv]); }
        __syncthreads();
        for (int i = 0; i < 8; ++i) { const float vv = sv[i * 64 + v]; float po = 0.f;
#pragma unroll
            for (int kk = 0; kk < 32; ++kk) { const int k = kg * 32 + kk; S[kk] = sa[i * 256 + k] * S[kk] + sk[i * 256 + k] * vv; po += sqv[i * 256 + k] * S[kk]; }
            part[(i * 8 + kg) * 64 + v] = po; }
        __syncthreads();
        { const int i = tid >> 6, vv = tid & 63; float o = 0.f;
#pragma unroll
            for (int q = 0; q < 8; ++q) o += part[(i * 8 + q) * 64 + vv];
            Ob[((size_t)b * SEQ + t0 + i) * 2048 + h * 512 + vs * 64 + vv] = o; }
    }
}
__device__ __forceinline__ void ph_gla_final(const float* Ob, const float* g, const u16* Rb, u16* yb, int gw, int NGW, int lane) {
    for (int item = gw; item < T * 4; item += NGW) { const int t = item >> 2, h = item & 3;
        const float* o = Ob + (size_t)t * 2048 + h * 512 + lane * 8; const f32x4 x0 = *(const f32x4*)o, x1 = *(const f32x4*)(o + 4);
        float ss = (x0[0] * x0[0] + x0[1] * x0[1]) + (x0[2] * x0[2] + x0[3] * x0[3]) + (x1[0] * x1[0] + x1[1] * x1[1]) + (x1[2] * x1[2] + x1[3] * x1[3]);
        ss = wave_sum(ss); const float r = rsqrtf(ss * (1.f / 512.f) + 1e-6f);
        const f32x4 g0 = *(const f32x4*)(g + lane * 8), g1 = *(const f32x4*)(g + lane * 8 + 4); const u32x4 rb = *(const u32x4*)(Rb + (size_t)t * 2048 + h * 512 + lane * 8);
        u32x4 w; w.x = cvtpk(x0[0] * r * g0[0] * bflo(rb.x), x0[1] * r * g0[1] * bfhi(rb.x)); w.y = cvtpk(x0[2] * r * g0[2] * bflo(rb.y), x0[3] * r * g0[3] * bfhi(rb.y));
        w.z = cvtpk(x1[0] * r * g1[0] * bflo(rb.z), x1[1] * r * g1[1] * bfhi(rb.z)); w.w = cvtpk(x1[2] * r * g1[2] * bflo(rb.w), x1[3] * r * g1[3] * bfhi(rb.w));
        *(u32x4*)(yb + (size_t)t * KAB + 512 + h * 512 + lane * 8) = w; }
}
constexpr int RT_LCNT = 131072, RT_GB = 131072 + 64, RT_REC = 131072 + 128;
__device__ __forceinline__ void ph_ln_router(const u16* __restrict__ pre, const float* __restrict__ g, const float* __restrict__ bb, const float* __restrict__ rw, const float* __restrict__ rb, u16* __restrict__ h1, u16* __restrict__ h1b,
                                             int* cnt, int* tok_of, int* tokinfo, LAS unsigned char* lds, int gw, int NGW, int lane, int wv) {
    LAS float* WL = (LAS float*)lds;
    int tid = WV_TID(wv); asm volatile("" : "+v"(tid));
    {
#pragma unroll 4
        for (int i = 0; i < 16; ++i) { const int idx = tid + 512 * i, c = idx >> 2, e4 = (idx & 3) * 4; const f32x4 w = *(const f32x4*)(rw + (size_t)c * 16 + e4);
            const int cp = ((c >> 2) & 1) * 1024 + (c >> 3) * 4 + (c & 3);
            WL[(e4 + 0) * 2048 + cp] = w[0]; WL[(e4 + 1) * 2048 + cp] = w[1]; WL[(e4 + 2) * 2048 + cp] = w[2]; WL[(e4 + 3) * 2048 + cp] = w[3]; } }
    if (tid < 16) ((LAS int*)(lds + RT_LCNT))[tid] = 0;
    __syncthreads();
    const float rbv = rb[lane & 15];
    int nrec = (tid >> 6) * 32;
    u32x4 nx[2][4];
    if (gw < T) { const int t1 = gw + NGW < T ? gw + NGW : gw;
#pragma unroll
        for (int jj = 0; jj < 4; ++jj) { nx[0][jj] = ((const u32x4*)(pre + (size_t)gw * D) + lane)[64 * jj]; nx[1][jj] = ((const u32x4*)(pre + (size_t)t1 * D) + lane)[64 * jj]; } }
    for (int t = gw; t < T; t += 2 * NGW) {
        const bool has1 = t + NGW < T; const int tt[2] = {t, has1 ? t + NGW : t};
        int lz = 0; asm volatile("" : "+v"(lz));
        u32x4 cur[2][4]; float rstd[2], mean[2];
#define LR_UNPK(q_, a_, b_) const f32x4 a_ = (f32x4){bflo((q_).x), bfhi((q_).x), bflo((q_).y), bfhi((q_).y)}, b_ = (f32x4){bflo((q_).z), bfhi((q_).z), bflo((q_).w), bfhi((q_).w)}
#pragma unroll
        for (int r = 0; r < 2; ++r) { float s = 0.f;
#pragma unroll
            for (int jj = 0; jj < 4; ++jj) { cur[r][jj] = nx[r][jj]; LR_UNPK(cur[r][jj], xa, xb);
                s += ((xa[0] + xa[1]) + (xa[2] + xa[3])) + ((xb[0] + xb[1]) + (xb[2] + xb[3])); }
            mean[r] = s; }
        { const int ta = t + 2 * NGW < T ? t + 2 * NGW : t, tb = t + 3 * NGW < T ? t + 3 * NGW : ta;
#pragma unroll
          for (int jj = 0; jj < 4; ++jj) { nx[0][jj] = ((const u32x4*)(pre + (size_t)ta * D) + lane)[64 * jj]; nx[1][jj] = ((const u32x4*)(pre + (size_t)tb * D) + lane)[64 * jj]; } }
#pragma unroll
        for (int r = 0; r < 2; ++r) { mean[r] = wave_sum(mean[r]) * (1.f / D); float s2 = 0.f;
#pragma unroll
            for (int jj = 0; jj < 4; ++jj) { LR_UNPK(cur[r][jj], xa, xb); const f32x4 da = xa - mean[r], db = xb - mean[r]; s2 += ((da[0] * da[0] + da[1] * da[1]) + (da[2] * da[2] + da[3] * da[3])) + ((db[0] * db[0] + db[1] * db[1]) + (db[2] * db[2] + db[3] * db[3])); }
            rstd[r] = rsqrtf(wave_sum(s2) * (1.f / D) + 1e-5f); }
        f32x2v lq[16];
#pragma unroll
        for (int e = 0; e < 16; ++e) lq[e] = (f32x2v){0.f, 0.f};
#pragma unroll
        for (int jj = 0; jj < 4; ++jj) { const int c = lane * 8 + 512 * jj;
            const f32x4 g0 = *(const f32x4*)(g + c + lz), g1 = *(const f32x4*)(g + c + lz + 4), b0 = *(const f32x4*)(bb + c + lz), b1 = *(const f32x4*)(bb + c + lz + 4);
            f32x4 y0[2], y1[2];
#pragma unroll
            for (int r = 0; r < 2; ++r) { LR_UNPK(cur[r][jj], xa, xb); y0[r] = (xa - mean[r]) * rstd[r] * g0 + b0; y1[r] = (xb - mean[r]) * rstd[r] * g1 + b1;
                { const size_t ro = (size_t)tt[r] * D + c;
                    u32x4 hk; hk.x = cvtpk(y0[r][0], y0[r][1]); hk.y = cvtpk(y0[r][2], y0[r][3]); hk.z = cvtpk(y1[r][0], y1[r][1]); hk.w = cvtpk(y1[r][2], y1[r][3]); *(u32x4*)(h1 + ro) = hk;
                    if (F8_MOE) { u32x2 w8; w8.x = cvt4_f8(y0[r][0] * F8_ACT, y0[r][1] * F8_ACT, y0[r][2] * F8_ACT, y0[r][3] * F8_ACT); w8.y = cvt4_f8(y1[r][0] * F8_ACT, y1[r][1] * F8_ACT, y1[r][2] * F8_ACT, y1[r][3] * F8_ACT); *(u32x2*)((unsigned char*)h1b + ro) = w8; }
                    else *(u32x4*)(h1b + ro) = hk; } }
            f32x2v yp[8];
#pragma unroll
            for (int k = 0; k < 4; ++k) { yp[k] = (f32x2v){y0[0][k], y0[1][k]}; yp[4 + k] = (f32x2v){y1[0][k], y1[1][k]}; }
#pragma unroll
            for (int e = 0; e < 16; ++e) { const f32x4 w4 = *(const LAS f32x4*)(WL + lz + e * 2048 + (lane + 64 * jj) * 4), w5 = *(const LAS f32x4*)(WL + lz + e * 2048 + 1024 + (lane + 64 * jj) * 4);
#pragma unroll
                for (int k = 0; k < 4; ++k) { lq[e] += yp[k] * w4[k]; lq[e] += yp[4 + k] * w5[k]; } } }
#pragma unroll
        for (int r = 0; r < 2; ++r) { if (r == 0 || has1) {
        float lg[16];
#pragma unroll
        for (int e = 0; e < 16; ++e) lg[e] = lq[e][r];
        float r8[8], r4[4], r2[2], r1;
        { const bool hi = lane & 1;
#pragma unroll
          for (int i = 0; i < 8; ++i) { const float keep = hi ? lg[2 * i + 1] : lg[2 * i], send = hi ? lg[2 * i] : lg[2 * i + 1]; r8[i] = keep + __shfl_xor(send, 1); } }
        { const bool hi = lane & 2;
#pragma unroll
          for (int i = 0; i < 4; ++i) { const float keep = hi ? r8[2 * i + 1] : r8[2 * i], send = hi ? r8[2 * i] : r8[2 * i + 1]; r4[i] = keep + __shfl_xor(send, 2); } }
        { const bool hi = lane & 4;
#pragma unroll
          for (int i = 0; i < 2; ++i) { const float keep = hi ? r4[2 * i + 1] : r4[2 * i], send = hi ? r4[2 * i] : r4[2 * i + 1]; r2[i] = keep + __shfl_xor(send, 4); } }
        { const bool hi = lane & 8; const float keep = hi ? r2[1] : r2[0], send = hi ? r2[0] : r2[1]; r1 = keep + __shfl_xor(send, 8); }
        r1 += __shfl_xor(r1, 16); r1 += __shfl_xor(r1, 32);
        const float mylogit = r1 + rbv;
        float mx = -INFINITY;
#pragma unroll
        for (int e = 0; e < 16; ++e) { lg[e] = __int_as_float(__builtin_amdgcn_readlane(__float_as_int(mylogit), e)); mx = fmaxf(mx, lg[e]); }
        float den = 0.f;
#pragma unroll
        for (int e = 0; e < 16; ++e) { lg[e] = expf(lg[e] - mx); den += lg[e]; }
        const float iden = 1.f / den;
        float best = -1.f; int i0 = 0, i1 = 1; float p0 = 0.f, p1 = 0.f;
#pragma unroll
        for (int gI = 0; gI < 4; ++gI) { float a = -1.f, b2 = -1.f; int ia = 0, ib = 0;
#pragma unroll
            for (int q = 0; q < 4; ++q) { const float pv = lg[gI * 4 + q] * iden; if (pv > a) { b2 = a; ib = ia; a = pv; ia = gI * 4 + q; } else if (pv > b2) { b2 = pv; ib = gI * 4 + q; } }
            const float gs = a + b2; if (gs > best) { best = gs; i0 = ia; i1 = ib; p0 = a; p1 = b2; } }
        if (lane == 0) { const float ws = 1.f / (p0 + p1);
            const int s0 = __hip_atomic_fetch_add((LAS int*)(lds + RT_LCNT) + i0, 1, __ATOMIC_RELAXED, __HIP_MEMORY_SCOPE_WORKGROUP), s1 = __hip_atomic_fetch_add((LAS int*)(lds + RT_LCNT) + i1, 1, __ATOMIC_RELAXED, __HIP_MEMORY_SCOPE_WORKGROUP);
            LAS int* rec = (LAS int*)(lds + RT_REC) + nrec * 8; rec[0] = tt[r]; rec[1] = i0; rec[2] = s0; rec[3] = __float_as_int(p0 * ws); rec[4] = i1; rec[5] = s1; rec[6] = __float_as_int(p1 * ws); }
        ++nrec; } }
    }
#undef LR_UNPK
    __syncthreads();
    if (tid < 16) { const int c = ((LAS int*)(lds + RT_LCNT))[tid]; int gb = 0; if (c > 0) gb = atomicAdd(cnt + 64 * tid, c); ((LAS int*)(lds + RT_GB))[tid] = gb; }
    __syncthreads();
    if (lane == 0) { const int wv = tid >> 6;
        for (int i = 0; i < nrec - wv * 32; ++i) { const LAS int* rec = (const LAS int*)(lds + RT_REC) + (wv * 32 + i) * 8; const int t = rec[0], i0 = rec[1], i1 = rec[4];
            const int s0 = ((LAS int*)(lds + RT_GB))[i0] + rec[2], s1 = ((LAS int*)(lds + RT_GB))[i1] + rec[5];
            tok_of[i0 * 8192 + s0] = t; tok_of[i1 * 8192 + s1] = t;
            int* ti = tokinfo + (size_t)t * 8; ti[0] = i0; ti[1] = s0; ti[2] = rec[3]; ti[3] = i1; ti[4] = s1; ti[5] = rec[6]; } }
    __syncthreads();
}
__device__ __forceinline__ void ph_gather(const u16* h1b, const int* cnt, const int* tok_of, u16* Xg, int gw, int NGW, int lane) {
    int pre[17], cn[16]; moe_prefix(cnt, lane, pre, cn);
    const int nrows = pre[16] * 256;
    for (int r = gw; r < nrows; r += NGW) { const int pr = r >> 8; int e = 0;
#pragma unroll
        for (int k = 1; k < 16; ++k) e += (pr >= pre[k]) ? 1 : 0;
        int pb = 0, ce = 0;
#pragma unroll
        for (int k = 0; k < 16; ++k) { if (e == k) { pb = pre[k]; ce = cn[k]; } }
        constexpr int RB = D * WEB, NJ = RB / 1024;
        const int slot = r - pb * 256; u32x4* dst = (u32x4*)((unsigned char*)Xg + (size_t)r * RB) + lane;
        if (slot < ce) { const int tok = tok_of[e * 8192 + slot]; const u32x4* src = (const u32x4*)((const unsigned char*)h1b + (size_t)tok * RB) + lane;
#pragma unroll
            for (int j = 0; j < NJ; ++j) dst[64 * j] = src[64 * j]; }
        else {
#pragma unroll
            for (int j = 0; j < NJ; ++j) dst[64 * j] = (u32x4){0u, 0u, 0u, 0u}; } }
}
__device__ __forceinline__ void ph_ln2_plain(const u16* h1, const u16* dn, const int* tokinfo, const int* cnt, const float* g, const float* bb, float* outf, u16* outh, u16* outb, int gw, int NGW, int lane) {
    int pre[17], cn[16]; moe_prefix(cnt, lane, pre, cn);
    for (int t = gw; t < T; t += NGW) {
        const int* ti = tokinfo + (size_t)t * 8; const int e0 = ti[0], e1 = ti[3]; int b0 = 0, b1 = 0;
#pragma unroll
        for (int k = 0; k < 16; ++k) { if (e0 == k) b0 = pre[k]; if (e1 == k) b1 = pre[k]; }
        const size_t r0 = (size_t)b0 * 256 + ti[1], r1 = (size_t)b1 * 256 + ti[4]; const float w0 = __int_as_float(ti[2]), w1 = __int_as_float(ti[5]);
        f32x4 v[4][2]; float s = 0.f;
#pragma unroll
        for (int j = 0; j < 4; ++j) { const int c = lane * 8 + 512 * j; const u32x4 hq_ = *(const u32x4*)(h1 + (size_t)t * D + c);
            const f32x4 h0 = (f32x4){bflo(hq_.x), bfhi(hq_.x), bflo(hq_.y), bfhi(hq_.y)}, h1v = (f32x4){bflo(hq_.z), bfhi(hq_.z), bflo(hq_.w), bfhi(hq_.w)};
            f32x4 ea0, ea1, eb0, eb1;
            if (DN_F8) { const u32x2 qa = *(const u32x2*)((const unsigned char*)dn + r0 * D + c), qb = *(const u32x2*)((const unsigned char*)dn + r1 * D + c);
                const f32x2v a0 = __builtin_amdgcn_cvt_pk_f32_fp8((int)qa.x, false), a1 = __builtin_amdgcn_cvt_pk_f32_fp8((int)qa.x, true), a2 = __builtin_amdgcn_cvt_pk_f32_fp8((int)qa.y, false), a3 = __builtin_amdgcn_cvt_pk_f32_fp8((int)qa.y, true);
                const f32x2v c0 = __builtin_amdgcn_cvt_pk_f32_fp8((int)qb.x, false), c1 = __builtin_amdgcn_cvt_pk_f32_fp8((int)qb.x, true), c2 = __builtin_amdgcn_cvt_pk_f32_fp8((int)qb.y, false), c3 = __builtin_amdgcn_cvt_pk_f32_fp8((int)qb.y, true);
                ea0 = (f32x4){a0[0], a0[1], a1[0], a1[1]} * (1.f / 16.f); ea1 = (f32x4){a2[0], a2[1], a3[0], a3[1]} * (1.f / 16.f); eb0 = (f32x4){c0[0], c0[1], c1[0], c1[1]} * (1.f / 16.f); eb1 = (f32x4){c2[0], c2[1], c3[0], c3[1]} * (1.f / 16.f); }
            else { const u32x4 qa = *(const u32x4*)(dn + r0 * D + c), qb = *(const u32x4*)(dn + r1 * D + c);
                ea0 = (f32x4){bflo(qa.x), bfhi(qa.x), bflo(qa.y), bfhi(qa.y)}; ea1 = (f32x4){bflo(qa.z), bfhi(qa.z), bflo(qa.w), bfhi(qa.w)}; eb0 = (f32x4){bflo(qb.x), bfhi(qb.x), bflo(qb.y), bfhi(qb.y)}; eb1 = (f32x4){bflo(qb.z), bfhi(qb.z), bflo(qb.w), bfhi(qb.w)}; }
            v[j][0] = h0 * DN_ALPHA + ea0 * w0 + eb0 * w1; v[j][1] = h1v * DN_ALPHA + ea1 * w0 + eb1 * w1;
            s += ((v[j][0][0] + v[j][0][1]) + (v[j][0][2] + v[j][0][3])) + ((v[j][1][0] + v[j][1][1]) + (v[j][1][2] + v[j][1][3])); }
        const float mean = wave_sum(s) * (1.f / D); float s2 = 0.f;
#pragma unroll
        for (int j = 0; j < 4; ++j)
#pragma unroll
            for (int q = 0; q < 2; ++q) { v[j][q] = v[j][q] - mean; s2 += (v[j][q][0] * v[j][q][0] + v[j][q][1] * v[j][q][1]) + (v[j][q][2] * v[j][q][2] + v[j][q][3] * v[j][q][3]); }
        const float rstd = rsqrtf(wave_sum(s2) * (1.f / D) + 1e-5f);
#pragma unroll
        for (int j = 0; j < 4; ++j) { const int c = lane * 8 + 512 * j;
            const f32x4 y0 = v[j][0] * rstd * *(const f32x4*)(g + c) + *(const f32x4*)(bb + c), y1 = v[j][1] * rstd * *(const f32x4*)(g + c + 4) + *(const f32x4*)(bb + c + 4);
            if (outf) { *(f32x4*)(outf + (size_t)t * D + c) = y0; *(f32x4*)(outf + (size_t)t * D + c + 4) = y1; }
            else { u32x4 hk; hk.x = cvtpk(y0[0], y0[1]); hk.y = cvtpk(y0[2], y0[3]); hk.z = cvtpk(y1[0], y1[1]); hk.w = cvtpk(y1[2], y1[3]); *(u32x4*)(outh + (size_t)t * D + c) = hk; }
            if (F8_IN) { u32x2 w8; w8.x = cvt4_f8(y0[0] * F8_ACT, y0[1] * F8_ACT, y0[2] * F8_ACT, y0[3] * F8_ACT); w8.y = cvt4_f8(y1[0] * F8_ACT, y1[1] * F8_ACT, y1[2] * F8_ACT, y1[3] * F8_ACT); *(u32x2*)((unsigned char*)outb + (size_t)t * D + c) = w8; }
            else { u32x4 pk; pk.x = cvtpk(y0[0], y0[1]); pk.y = cvtpk(y0[2], y0[3]); pk.z = cvtpk(y1[0], y1[1]); pk.w = cvtpk(y1[2], y1[3]); *(u32x4*)(outb + (size_t)t * D + c) = pk; } }
    }
}

__device__ __forceinline__ void ph_ln2(const u16* h1, const u16* dn, const int* tokinfo, const int* cnt, const float* g, const float* bb, float* outf, u16* outh, u16* outb, int gw, int NGW, int lane) {
    if (!DN_F8) { ph_ln2_plain(h1, dn, tokinfo, cnt, g, bb, outf, outh, outb, gw, NGW, lane); return; }
    int pre[17], cn[16]; moe_prefix(cnt, lane, pre, cn);
    if (gw >= T) return;
    u32x4 rh[4]; u32x2 ra[4], rb[4]; float nw0, nw1;
    u32x4 tiA; u32x2 tiB;
#define LN2_TI(tt) do { const int* ti_ = tokinfo + (size_t)(tt) * 8; tiA = *(const u32x4*)ti_; tiB = *(const u32x2*)(ti_ + 4); } while (0)
#define LN2_ISSUE(tt) do { const int e0 = (int)tiA.x, e1 = (int)tiA.w; int b0 = 0, b1 = 0; \
        _Pragma("unroll") for (int k = 0; k < 16; ++k) { if (e0 == k) b0 = pre[k]; if (e1 == k) b1 = pre[k]; } \
        const size_t r0 = (size_t)b0 * 256 + (int)tiA.y, r1 = (size_t)b1 * 256 + (int)tiB.x; nw0 = __int_as_float((int)tiA.z); nw1 = __int_as_float((int)tiB.y); \
        _Pragma("unroll") for (int j = 0; j < 4; ++j) { const int c = lane * 8 + 512 * j; rh[j] = *(const u32x4*)(h1 + (size_t)(tt) * D + c); \
            ra[j] = *(const u32x2*)((const unsigned char*)dn + r0 * D + c); rb[j] = *(const u32x2*)((const unsigned char*)dn + r1 * D + c); } } while (0)
    LN2_TI(gw); LN2_ISSUE(gw);
    { const int t1 = gw + NGW < T ? gw + NGW : gw; LN2_TI(t1); }
    for (int t = gw; t < T; t += NGW) {
        const float w0 = nw0, w1 = nw1;
        f32x4 v[4][2]; float s = 0.f;
#pragma unroll
        for (int j = 0; j < 4; ++j) { const u32x4 hq_ = rh[j]; const u32x2 qa = ra[j], qb = rb[j];
            const f32x4 h0 = (f32x4){bflo(hq_.x), bfhi(hq_.x), bflo(hq_.y), bfhi(hq_.y)}, h1v = (f32x4){bflo(hq_.z), bfhi(hq_.z), bflo(hq_.w), bfhi(hq_.w)};
            const f32x2v a0 = __builtin_amdgcn_cvt_pk_f32_fp8((int)qa.x, false), a1 = __builtin_amdgcn_cvt_pk_f32_fp8((int)qa.x, true), a2 = __builtin_amdgcn_cvt_pk_f32_fp8((int)qa.y, false), a3 = __builtin_amdgcn_cvt_pk_f32_fp8((int)qa.y, true);
            const f32x2v c0 = __builtin_amdgcn_cvt_pk_f32_fp8((int)qb.x, false), c1 = __builtin_amdgcn_cvt_pk_f32_fp8((int)qb.x, true), c2 = __builtin_amdgcn_cvt_pk_f32_fp8((int)qb.y, false), c3 = __builtin_amdgcn_cvt_pk_f32_fp8((int)qb.y, true);
            const f32x4 ea0 = (f32x4){a0[0], a0[1], a1[0], a1[1]} * (1.f / 16.f), ea1 = (f32x4){a2[0], a2[1], a3[0], a3[1]} * (1.f / 16.f), eb0 = (f32x4){c0[0], c0[1], c1[0], c1[1]} * (1.f / 16.f), eb1 = (f32x4){c2[0], c2[1], c3[0], c3[1]} * (1.f / 16.f);
            v[j][0] = h0 * DN_ALPHA + ea0 * w0 + eb0 * w1; v[j][1] = h1v * DN_ALPHA + ea1 * w0 + eb1 * w1;
            s += ((v[j][0][0] + v[j][0][1]) + (v[j][0][2] + v[j][0][3])) + ((v[j][1][0] + v[j][1][1]) + (v[j][1][2] + v[j][1][3])); }
        { const int tn = t + NGW < T ? t + NGW : t, tnn = tn + NGW < T ? tn + NGW : tn; LN2_ISSUE(tn); LN2_TI(tnn); }
        const float mean = wave_sum(s) * (1.f / D); float s2 = 0.f;
#pragma unroll
        for (int j = 0; j < 4; ++j)
#pragma unroll
            for (int q = 0; q < 2; ++q) { v[j][q] = v[j][q] - mean; s2 += (v[j][q][0] * v[j][q][0] + v[j][q][1] * v[j][q][1]) + (v[j][q][2] * v[j][q][2] + v[j][q][3] * v[j][q][3]); }
        const float rstd = rsqrtf(wave_sum(s2) * (1.f / D) + 1e-5f);
#pragma unroll
        for (int j = 0; j < 4; ++j) { const int c = lane * 8 + 512 * j;
            const f32x4 y0 = v[j][0] * rstd * *(const f32x4*)(g + c) + *(const f32x4*)(bb + c), y1 = v[j][1] * rstd * *(const f32x4*)(g + c + 4) + *(const f32x4*)(bb + c + 4);
            if (outf) { *(f32x4*)(outf + (size_t)t * D + c) = y0; *(f32x4*)(outf + (size_t)t * D + c + 4) = y1; }
            else { u32x4 hk; hk.x = cvtpk(y0[0], y0[1]); hk.y = cvtpk(y0[2], y0[3]); hk.z = cvtpk(y1[0], y1[1]); hk.w = cvtpk(y1[2], y1[3]); *(u32x4*)(outh + (size_t)t * D + c) = hk; }
            if (F8_IN) { u32x2 w8; w8.x = cvt4_f8(y0[0] * F8_ACT, y0[1] * F8_ACT, y0[2] * F8_ACT, y0[3] * F8_ACT); w8.y = cvt4_f8(y1[0] * F8_ACT, y1[1] * F8_ACT, y1[2] * F8_ACT, y1[3] * F8_ACT); *(u32x2*)((unsigned char*)outb + (size_t)t * D + c) = w8; }
            else { u32x4 pk; pk.x = cvtpk(y0[0], y0[1]); pk.y = cvtpk(y0[2], y0[3]); pk.z = cvtpk(y1[0], y1[1]); pk.w = cvtpk(y1[2], y1[3]); *(u32x4*)(outb + (size_t)t * D + c) = pk; } }
    }
#undef LN2_TI
#undef LN2_ISSUE
}

__global__ void __launch_bounds__(512, 2) fwd(Args a) {
    extern __shared__ __attribute__((aligned(16))) unsigned char lds_raw[];
    LAS unsigned char* lds = (LAS unsigned char*)lds_raw;
    volatile LAS unsigned* MISC = (volatile LAS unsigned*)(lds + MISC_OFF);
    const int tid = threadIdx.x;
    const int wv_s = __builtin_amdgcn_readfirstlane(tid >> 6);
    const int G = gridDim.x, bx = blockIdx.x, NGW = G * 8, NGT = G * 512;
#define PH_IDS() int tid_ = WV_TID(wv_s); asm volatile("" : "+v"(tid_)); const int lane = tid_ & 63, wave = __builtin_amdgcn_readfirstlane(tid_ >> 6), gw = bx * 8 + wave, gt = bx * 512 + tid_; (void)gw; (void)gt; (void)lane; (void)wave; size_t wz_ = 0; asm volatile("" : "+s"(wz_)); unsigned char* wsl = a.ws + wz_
    unsigned char* ws = a.ws; unsigned* ctl = (unsigned*)(ws + WS_CTL);
    if (tid < 64) MISC[tid] = 0u;
    __syncthreads();
    const bool multi = ONE_LAUNCH || (a.ph_hi - a.ph_lo) > 1;
    XcdBarrier bar; bar.bar = ctl + CW_BAR; bar.x = 0; bar.st = nullptr;
    if (multi) bar = xcd_barrier_post(ctl + CW_BAR, MISC + 8);
    const int lo = a.ph_lo, hi = a.ph_hi;
#ifndef PHMASK
#define PHMASK 0xFFFFFFFFu
#endif
#if ONE_LAUNCH
#define IN(k) true
#else
#define IN(k) (lo <= (k) && (k) < hi)
#endif
#define EN(j) ((PHMASK >> (j)) & 1u)
#ifndef REPMASK
#define REPMASK 0u
#endif
#ifndef REPN
#define REPN 1
#endif
#define REP(j) for (int rp_ = 0; rp_ <= (int)(REPN * ((REPMASK >> (j)) & 1u)); ++rp_)
#define REPBAR() do { if (rp_ > 0 || false) {} } while (0)
#ifndef SEAMX
#define SEAMX 1
#endif
#define SEAM(k) do { if (IN(k) && IN((k) + 1)) { for (int sx_ = 0; sx_ < SEAMX; ++sx_) xcd_barrier(bar, wv_s); } } while (0)
#define W16(off) ((u16*)(wsl + (off)))
#define WF(off) ((float*)(wsl + (off)))
#define WI(off) ((int*)(wsl + (off)))
    REP(11) if (rp_ == 0 || (xcd_barrier(bar, wv_s), true)) if (EN(11) && IN(0)) { PH_IDS(); ph_prologue(a, lds, gw, NGW, wave, lane); }
    SEAM(0);
    for (int l = 0; l < DEPTH; ++l) {
        const int pb = 1 + NPH_LAYER * l;
        REP(0) if (rp_ == 0 || (xcd_barrier(bar, wv_s), true)) if (EN(0) && IN(pb + 0)) { PH_IDS(); ProbInProj P; P.A = W16(P_HB); P.Bt = W16(WS_WIN + l * SZ_WIN); P.G = G; P.c = bx; P.ws = wsl; P.gkl = WF(P_GKL); P.tab = WF(WS_TAB);
            const int nbg = (BG_WGS > 0 && G >= 4 * BG_WGS) ? BG_WGS : 0;
            if (BG_WGS > 0 && nbg == 0) { ph_bgconv(a, lds, l == 0 ? BGP_A : BGP_D, l == 0 ? BGP_B : BGP_E, gw, NGW, wave, lane); __syncthreads(); }
            if (nbg > 0) P.G = G - nbg;
            if (nbg > 0 && bx >= G - nbg) ph_bgconv(a, lds, l == 0 ? BGP_A : BGP_D, l == 0 ? BGP_B : BGP_E, (bx - (G - nbg)) * 8 + wave, nbg * 8, wave, lane);
            else pg8::gemm_run(lds, P, wv_s); }
        SEAM(pb + 0);
        REP(1) if (rp_ == 0 || (xcd_barrier(bar, wv_s), true)) if (EN(1) && IN(pb + 1)) { PH_IDS();
#if ATTN_SIMPLE
            ph_attn_simple(W16(P_QA), W16(P_KA), W16(P_VA), W16(P_OA), WF(P_LSE), lds, gw, NGW, wave, lane);
#else
            for (int r2_ = 0; r2_ <= (int)((REPMASK >> 14) & 1u); ++r2_) ph_attn(W16(P_QA), W16(P_KA), W16(P_VA), W16(P_OA), WF(P_LSE), lds, bx, G, wv_s);
#endif
#if !GLA_SIMPLE
            for (int r3_ = 0; r3_ <= (int)((REPMASK >> 15) & 1u); ++r3_) ph_gla_prep(W16(P_QB), W16(P_KB), W16(P_VB), WF(P_GKL), a.w_gk2 + (size_t)l * 16 * 1024, a.b_gk + (size_t)l * 1024, W16(P_QT), W16(P_KDT), W16(P_VT), W16(P_ATT), WF(P_DEC), lds, bx, G, wv_s);
#endif
        }
        SEAM(pb + 1);
        REP(2) if (rp_ == 0 || (xcd_barrier(bar, wv_s), true)) if (EN(2) && IN(pb + 2)) { PH_IDS();
#if GLA_SIMPLE
            ph_gla_simple(W16(P_QB), W16(P_KB), W16(P_VB), WF(P_GKL), a.w_gk2 + (size_t)l * 16 * 1024, a.b_gk + (size_t)l * 1024, WF(P_OB), lds);
#else
#ifdef PROBE_SCAN_NOSTORE
            ph_gla_scan<false>(W16(P_KDT), W16(P_VT), WF(P_DEC), W16(P_SN), lds, bx, G, wv_s);
#endif
            for (int r2_ = 0; r2_ <= (int)((REPMASK >> 12) & 1u); ++r2_) ph_gla_scan(W16(P_KDT), W16(P_VT), WF(P_DEC), W16(P_SN), lds, bx, G, wv_s);
#endif
            for (int r3_ = 0; r3_ <= (int)((REPMASK >> 13) & 1u); ++r3_) ph_ya(W16(P_OA), WF(P_LSE), W16(P_YAB), gt, NGT); }
        SEAM(pb + 2);
        REP(3) if (rp_ == 0 || (xcd_barrier(bar, wv_s), true)) if (EN(3) && IN(pb + 3)) { PH_IDS();
#if GLA_SIMPLE
            ph_gla_final(WF(P_OB), a.g_gla + (size_t)l * 512, W16(P_RB), W16(P_YAB), gw, NGW, lane);
#else
#ifdef PROBE_OUT_MODE
            ph_gla_out<PROBE_OUT_MODE>(W16(P_SN), W16(P_QT), W16(P_VT), W16(P_ATT), a.g_gla + (size_t)l * 512, W16(P_RB), W16(P_YAB), lds, bx, G, wv_s);
#endif
            ph_gla_out(W16(P_SN), W16(P_QT), W16(P_VT), W16(P_ATT), a.g_gla + (size_t)l * 512, W16(P_RB), W16(P_YAB), lds, bx, G, wv_s);
#endif
        }
        SEAM(pb + 3);
        REP(4) if (rp_ == 0 || (xcd_barrier(bar, wv_s), true)) if (EN(4) && IN(pb + 4)) { PH_IDS(); ProbMerge P; P.yab = W16(P_YAB); P.PabT = W16(WS_PAB + l * SZ_PAB); P.Ga = W16(P_GA); P.Gb = W16(P_GB); P.mrg = W16(P_MRG); P.G = G; P.c = bx;
            pg8::gemm_run(lds, P, wv_s); }
        SEAM(pb + 4);
        REP(5) if (rp_ == 0 || (xcd_barrier(bar, wv_s), true)) if (EN(5) && IN(pb + 5)) { PH_IDS(); ProbWo P; P.A = W16(P_MRG); P.Bt = W16(WS_WO + l * SZ_WO); P.hres = l == 0 ? (const void*)a.x : (const void*)W16(P_HC); P.hres_bf16 = l != 0; P.pre1 = W16(P_PRE1); P.G = G; P.c = bx;
            pg8::gemm_run(lds, P, wv_s); }
        SEAM(pb + 5);
        REP(6) if (rp_ == 0 || (xcd_barrier(bar, wv_s), true)) if (EN(6) && IN(pb + 6)) { PH_IDS(); ph_ln_router(W16(P_PRE1), a.ln1_g + (size_t)l * D, a.ln1_b + (size_t)l * D, a.router_w, a.router_b, W16(P_H1), W16(P_H1B), WI(WS_CTL) + CW_CNT + 2048 * l + (((REPMASK >> 6) & 1u) && rp_ == 0 ? 1024 : 0), WI(P_TOK) + 131072 * l, WI(P_TI), lds, gw, NGW, lane, wv_s); }
        SEAM(pb + 6);
        REP(8) if (rp_ == 0 || (xcd_barrier(bar, wv_s), true)) if (EN(8) && IN(pb + 8)) { PH_IDS(); ProbGateUp P; P.Xg = W16(P_H1B); P.tok = WI(P_TOK) + 131072 * l; P.pcnt = (unsigned*)WI(WS_CTL) + CW_PANEL + 5120 * l; P.Wgu = W16(WS_WGU + l * SZ_WGU); P.act = W16(P_ACT); P.G = G; P.c = bx;
            const int nbg = (BG_WGS > 0 && G >= 4 * BG_WGS) ? (l == 0 ? BG_WGS : BG_GU1) : 0;
            if (BG_WGS > 0 && nbg == 0) { ph_bgconv(a, lds, l == 0 ? BGP_B : BGP_E, l == 0 ? BGP_C : BGP_F, gw, NGW, wave, lane); __syncthreads(); }
            if (nbg > 0) P.G = G - nbg;
            if (nbg > 0 && bx >= G - nbg) ph_bgconv(a, lds, l == 0 ? BGP_B : BGP_E, l == 0 ? BGP_C : BGP_F, (bx - (G - nbg)) * 8 + wave, nbg * 8, wave, lane);
            else { int cn[16]; moe_prefix(WI(WS_CTL) + CW_CNT + 2048 * l, lane, P.pre, cn); pg8::gemm_run(lds, P, wv_s); } }
        if (!MOE_CHAIN) SEAM(pb + 8);
        REP(9) if (rp_ == 0 || (xcd_barrier(bar, wv_s), true)) if (EN(9) && IN(pb + 9)) { PH_IDS(); ProbDown P; P.pcnt = (unsigned*)WI(WS_CTL) + CW_PANEL + 5120 * l; P.tmo = (unsigned*)WI(WS_CTL) + CW_TMO; P.act = W16(P_ACT); P.Wd = W16(WS_WD + l * SZ_WD); P.dn = W16(P_DN); P.G = G; P.c = bx;
            const bool hostd = BG_WGS > 0 && l == 0 && G >= 4 * BG_WGS;
            if (BG_WGS > 0 && l == 0 && !hostd) { ph_bgconv(a, lds, BGP_C, BGP_D, gw, NGW, wave, lane); __syncthreads(); }
            if (hostd) P.G = G - BG_WGS;
            if (hostd && bx >= G - BG_WGS) ph_bgconv(a, lds, BGP_C, BGP_D, (bx - (G - BG_WGS)) * 8 + wave, BG_WGS * 8, wave, lane);
            else { int cn[16]; moe_prefix(WI(WS_CTL) + CW_CNT + 2048 * l, lane, P.pre, cn); pg8::gemm_run(lds, P, wv_s); } }
        SEAM(pb + 9);
        REP(10) if (rp_ == 0 || (xcd_barrier(bar, wv_s), true)) if (EN(10) && IN(pb + 10)) { PH_IDS(); ph_ln2(W16(P_H1), W16(P_DN), WI(P_TI), WI(WS_CTL) + CW_CNT + 2048 * l, a.ln2_g + (size_t)l * D, a.ln2_b + (size_t)l * D, l == DEPTH - 1 ? a.out : (float*)nullptr, W16(P_HC), W16(P_HB), gw, NGW, lane); }
        SEAM(pb + 10);
    }
#undef IN
#undef SEAM
}

#ifndef ONE_LAUNCH
#define ONE_LAUNCH 1
#endif
extern "C" void kernel_launch(void* const* d_in, const int* in_sizes, int n_in, void* d_out, int out_size, void* d_ws, size_t ws_size, hipStream_t stream) {
    static int grid = 0;
    if (grid == 0) {
        if (n_in != 18 || ws_size < P_END) { fprintf(stderr, "kernel_launch: n_in %d ws %zu (need %zu): nothing launched\n", n_in, ws_size, (size_t)P_END); grid = -1; return; }
        int dev = 0, cus = 0;
        if (hipGetDevice(&dev) != hipSuccess || hipDeviceGetAttribute(&cus, hipDeviceAttributeMultiprocessorCount, dev) != hipSuccess) { grid = -1; return; }
        if (hipFuncSetAttribute((const void*)fwd, hipFuncAttributeMaxDynamicSharedMemorySize, LDS_BYTES) != hipSuccess) { fprintf(stderr, "kernel_launch: hipFuncSetAttribute failed\n"); grid = -1; return; }
        int per_cu = 0;
        if (hipOccupancyMaxActiveBlocksPerMultiprocessor(&per_cu, (const void*)fwd, 512, LDS_BYTES) != hipSuccess || per_cu < 1) fprintf(stderr, "kernel_launch: occupancy query says %d blocks per CU\n", per_cu);
        (void)hipGetLastError();
        grid = cus;
    }
    if (grid < 0) return;
    (void)hipMemsetAsync((char*)d_ws + WS_CTL, 0, CTL_ZERO_BYTES, stream);
    Args a{};
    a.x = (const float*)d_in[0]; a.pos = (const int*)d_in[1]; a.w_in = (const float*)d_in[2]; a.w_gk2 = (const float*)d_in[3]; a.b_gk = (const float*)d_in[4]; a.g_gla = (const float*)d_in[5];
    a.p_a = (const float*)d_in[6]; a.p_b = (const float*)d_in[7]; a.w_o = (const float*)d_in[8]; a.ln1_g = (const float*)d_in[9]; a.ln1_b = (const float*)d_in[10]; a.router_w = (const float*)d_in[11];
    a.router_b = (const float*)d_in[12]; a.w_gate = (const float*)d_in[13]; a.w_up = (const float*)d_in[14]; a.w_down = (const float*)d_in[15]; a.ln2_g = (const float*)d_in[16]; a.ln2_b = (const float*)d_in[17];
    a.out = (float*)d_out; a.ws = (unsigned char*)d_ws;
#if ONE_LAUNCH
#ifdef EXTRA_PROLOGUE
    a.ph_lo = 0; a.ph_hi = 1; hipLaunchKernelGGL(fwd, dim3(grid), dim3(512), LDS_BYTES, stream, a);
#endif
    a.ph_lo = 0; a.ph_hi = NPH; hipLaunchKernelGGL(fwd, dim3(grid), dim3(512), LDS_BYTES, stream, a);
#else
    for (int ph = 0; ph < NPH; ++ph) { a.ph_lo = ph; a.ph_hi = ph + 1; hipLaunchKernelGGL(fwd, dim3(grid), dim3(512), LDS_BYTES, stream, a); }
#endif
}
```

```cpp
#include <hip/hip_runtime.h>
#include <stdint.h>
#include <stdio.h>
#include <math.h>

typedef unsigned short u16;
constexpr int T = 8192, SEQ = 4096, D = 2048, NIN = 14864, DEPTH = 2;
constexpr int NE = 16, DFF = 1408;
constexpr size_t MiB = 1u << 20;
constexpr float DN_ALPHA = 1.41421356237309515f;
constexpr int C_QA = 0, C_KA = 1536, C_VA = 3072, C_QB = 4608, C_KB = 5632, C_VB = 6656, C_RB = 8704, C_GK = 10752, C_GA = 10768, C_GB = 12816;

__device__ __forceinline__ u16 f2bf(float f) { unsigned u = __float_as_uint(f); u += 0x7fffu + ((u >> 16) & 1u); return (u16)(u >> 16); }
__device__ __forceinline__ float bf2f(u16 b) { return __uint_as_float(((unsigned)b) << 16); }
__device__ __forceinline__ float wave_sum(float v) {
#pragma unroll
    for (int o = 1; o < 64; o <<= 1) v += __shfl_xor(v, o);
    return v;
}
__device__ __forceinline__ float wave_max(float v) {
#pragma unroll
    for (int o = 1; o < 64; o <<= 1) v = fmaxf(v, __shfl_xor(v, o));
    return v;
}

#define LAS __attribute__((address_space(3)))
#ifndef ATTN_SIMPLE
#define ATTN_SIMPLE 0
#endif
#ifndef GLA_SIMPLE
#define GLA_SIMPLE 0
#endif
#ifndef ONE_LAUNCH
#define ONE_LAUNCH 1
#endif
#ifndef BG_WGS
#define BG_WGS 64
#endif
constexpr int NP_WIN = 16 * ((NIN + 63) / 64), NP_LAYER = NP_WIN + 128 + 512 + 512 + 3 * 5632, NP_ALL = 2 * NP_LAYER;
constexpr int BGP_A = BG_WGS ? NP_WIN : NP_ALL;
#ifndef BG_PA
#define BG_PA 26
#endif
#ifndef BG_PB
#define BG_PB 12
#endif
constexpr int BGP_B = BG_WGS ? BGP_A + BG_WGS * 8 * BG_PA : NP_ALL;
#ifndef BG_GU0
#define BG_GU0 56
#endif
constexpr int BGP_C = BG_WGS ? BGP_B + BG_GU0 * 8 * BG_PB : NP_ALL;
constexpr int BGP_D = BG_WGS ? NP_LAYER + NP_WIN : NP_ALL;
constexpr int BGP_E = BG_WGS ? BGP_D + BG_WGS * 8 * BG_PA : NP_ALL;
constexpr int BGP_F = NP_ALL;
#ifndef BG_GUMIN
#define BG_GUMIN 48
#endif
#ifndef BG_GU1
#define BG_GU1 56
#endif
static_assert(BG_WGS == 0 || (BGP_B >= NP_WIN + 128 + 512 + 512 + 2 * 5632 && BGP_C >= NP_LAYER && BGP_C <= BGP_D && BGP_E >= NP_LAYER + NP_WIN + 128 + 512 + 512 + 2 * 5632 && BGP_E <= NP_ALL), "background conversion ranges vs first use");
#ifndef WT_STORES
#define WT_STORES 0
#endif
#ifndef BAUX_MOE
#define BAUX_MOE 0
#endif
#ifndef HALF_UNITS
#define HALF_UNITS 1
#endif
#ifndef MOE_CHAIN
#define MOE_CHAIN 0
#endif
#ifndef DN_F8
#define DN_F8 1
#endif
#ifndef SN_F8
#define SN_F8 1
#endif
#ifndef USE_F8
#define USE_F8 15
#endif
constexpr bool F8_IN = (USE_F8 & 1) != 0, F8_MOE = (USE_F8 & 2) != 0, F8_WO = (USE_F8 & 4) != 0, F8_MRG = (USE_F8 & 8) != 0;
typedef short bf16x8 __attribute__((ext_vector_type(8)));
typedef float f32x4 __attribute__((ext_vector_type(4)));
typedef unsigned u32x4 __attribute__((ext_vector_type(4)));
typedef unsigned u32x2 __attribute__((ext_vector_type(2)));
typedef int i32x4 __attribute__((ext_vector_type(4)));
typedef int i32x8 __attribute__((ext_vector_type(8)));
typedef float f32x2_t __attribute__((ext_vector_type(2)));
typedef __bf16 bf16x2_t __attribute__((ext_vector_type(2)));
__device__ __forceinline__ unsigned cvtpk(float lo, float hi) { f32x2_t v = {lo, hi}; bf16x2_t b = __builtin_convertvector(v, bf16x2_t); return __builtin_bit_cast(unsigned, b); }
__device__ __forceinline__ float bflo(unsigned w) { return __uint_as_float(w << 16); }
__device__ __forceinline__ float bfhi(unsigned w) { return __uint_as_float(w & 0xffff0000u); }
typedef float f32x2v __attribute__((ext_vector_type(2)));
__device__ __forceinline__ bf16x8 ld_f8x8(const unsigned char* p) {
    const u32x2 q = *(const u32x2*)p; const f32x2v a = __builtin_amdgcn_cvt_pk_f32_fp8((int)q.x, false), b = __builtin_amdgcn_cvt_pk_f32_fp8((int)q.x, true), c = __builtin_amdgcn_cvt_pk_f32_fp8((int)q.y, false), d = __builtin_amdgcn_cvt_pk_f32_fp8((int)q.y, true);
    u32x4 w; w.x = cvtpk(a[0], a[1]); w.y = cvtpk(b[0], b[1]); w.z = cvtpk(c[0], c[1]); w.w = cvtpk(d[0], d[1]); return __builtin_bit_cast(bf16x8, w); }
constexpr float F8_ACT = 8.f, F8_WGT = 64.f, F8_INV = 1.f / (F8_ACT * F8_WGT);
__device__ __forceinline__ unsigned cvt4_f8(float a, float b, float c, float d) {
    a = fminf(fmaxf(a, -448.f), 448.f); b = fminf(fmaxf(b, -448.f), 448.f); c = fminf(fmaxf(c, -448.f), 448.f); d = fminf(fmaxf(d, -448.f), 448.f);
    int r = __builtin_amdgcn_cvt_pk_fp8_f32(a, b, 0, false); r = __builtin_amdgcn_cvt_pk_fp8_f32(c, d, r, true); return (unsigned)r; }
__device__ __forceinline__ int lane_id() { int l; asm volatile("v_mbcnt_lo_u32_b32 %0, -1, 0\n\tv_mbcnt_hi_u32_b32 %0, -1, %0" : "=v"(l)); return l; }
#define WV_TID(wv_) ((wv_) * 64 + lane_id())
__device__ __forceinline__ float fsigmoid(float x) { return __builtin_amdgcn_rcpf(1.f + __expf(-x)); }

constexpr size_t WS_CTL = 0, CTL_ZERO_BYTES = 131072;
constexpr size_t WS_TAB = 1 * MiB;
constexpr int NWIN = 15104;
constexpr size_t WS_WIN = 2 * MiB, SZ_WIN = (size_t)NWIN * D * 2;
constexpr int KAB = 2560;
constexpr size_t WS_PAB = WS_WIN + 2 * SZ_WIN, SZ_PAB = (size_t)D * KAB * 2;
constexpr size_t WS_WO = WS_PAB + 2 * SZ_PAB, SZ_WO = (size_t)D * D * 2;
constexpr size_t WS_WGU = WS_WO + 2 * SZ_WO, SZ_WGU = (size_t)NE * 2816 * D * 2;
constexpr size_t WS_WD = WS_WGU + 2 * SZ_WGU, SZ_WD = (size_t)NE * D * DFF * 2;
constexpr size_t WS_WEND = WS_WD + 2 * SZ_WD;
static_assert(WS_WEND <= 684 * MiB, "weights");

constexpr size_t P_HC = 684 * MiB, P_HB = 748 * MiB;
constexpr size_t P_QA = 780 * MiB, P_KA = 804 * MiB, P_VA = 828 * MiB, P_QB = 852 * MiB, P_KB = 868 * MiB, P_VB = 884 * MiB, P_RB = 916 * MiB, P_GA = 948 * MiB, P_GB = 980 * MiB;
constexpr size_t P_GKL = 1012 * MiB, P_OA = 1013 * MiB, P_LSE = 1037 * MiB, P_YAB = 1038 * MiB;
constexpr size_t P_QT = 1078 * MiB, P_KDT = 1094 * MiB, P_ATT = 1110 * MiB, P_DEC = 1114 * MiB, P_SN = 1115 * MiB;
constexpr size_t P_OB = 1115 * MiB;
constexpr size_t P_MRG = 780 * MiB, P_PRE1 = 884 * MiB, P_H1 = 948 * MiB, P_H1B = 1046 * MiB, P_XG = 1078 * MiB, P_ACT = 1158 * MiB, P_DN = 812 * MiB;
static_assert(P_VA - P_KA == P_KA - P_QA && P_GA - P_RB == P_RB - P_VB && P_GB - P_GA == P_RB - P_VB, "in-projection output groups must be equally spaced");
constexpr size_t P_TOK = 1243 * MiB, P_TI = 1244 * MiB, P_VT = 1245 * MiB, P_END = 1277 * MiB;
constexpr int MAXROWS = 20480;

constexpr int LDS_BYTES = 155648;
constexpr int MISC_OFF = 147456;

namespace pg8 {
constexpr int BM = 256, BK = 64, HALF = 128, HTB = HALF * BK * 2, STAGE_BYTES = 8 * HTB, NXCD = 8, WGM = 8;
__host__ __device__ __forceinline__ int lds_byte(int r, int c) { const int st = (r >> 4) * 2 + (c >> 5), rr = r & 15, cc = c & 31, ob = rr * 64 + cc * 2; return st * 1024 + (ob ^ (((ob >> 9) & 1) << 5)); }
__host__ __device__ __forceinline__ void stage_rc(int b, int& R, int& C) { const int st = b / 1024, sb = b % 1024, swz = sb ^ (((sb >> 9) & 1) << 5); R = (st >> 1) * 16 + swz / 64; C = (st & 1) * 32 + (swz % 64) / 2; }
__host__ __device__ __forceinline__ int perm32(int rho) { const int n = rho >> 4, i = rho & 15; return 8 * (i >> 2) + 4 * n + (i & 3); }
__device__ __forceinline__ int xcd_remap(int L, int nwg) { const int q = nwg / NXCD, r = nwg % NXCD, xcd = L % NXCD, off = L / NXCD; return (xcd < r ? xcd * (q + 1) : r * (q + 1) + (xcd - r) * q) + off; }
__device__ __forceinline__ bool deal(int i, int c, int G, int nwg, bool halves, int& L, int& hm) {
    const int nfull = nwg / G, R = nwg - nfull * G; hm = 0;
    if (i < nfull) { L = i * G + c; return true; }
    if (i > nfull || R == 0) return false;
    if (halves && 2 * R <= G && 16 * ((R - 1) >> 3) + 15 < G) { const int idx = ((c >> 4) << 3) + (c & 7); if (idx >= R) return false; L = nfull * G + idx; hm = 1 + ((c >> 3) & 1); return true; }
    if (halves && 2 * R <= G) { if (c >= 2 * R) return false; L = nfull * G + (c >> 1); hm = 1 + (c & 1); return true; }
    if (c >= R) return false; L = nfull * G + c; return true; }
template <int WGM_ = WGM> __device__ __forceinline__ void tile_of(int wgid, int nM, int nN, int& pm, int& pn) { constexpr int WGM = WGM_; const int nig = WGM * nN, gid = wgid / nig, fm = gid * WGM, gsz = (nM - fm) < WGM ? (nM - fm) : WGM; pm = fm + ((wgid % nig) % gsz); pn = (wgid % nig) / gsz; }

struct GUnit { const char* A; const char* B; unsigned lda2, ldb2; int nt, pm, pn, aux, hm; };

template <class P>
__device__ __forceinline__ void gemm_run(LAS unsigned char* lds, const P& S, int wv) {
    int tid = WV_TID(wv); asm volatile("" : "+v"(tid));
    const int wid = __builtin_amdgcn_readfirstlane(tid >> 6), lane = tid & 63, wr = wid >> 2, wc = wid & 3, fr = lane & 15, fq = lane >> 4;
    int sRA[2], sRB[2], sC[2];
#pragma unroll
    for (int i = 0; i < 2; ++i) { int R, C; stage_rc(tid * 16 + i * 8192, R, C); sRA[i] = R; sRB[i] = P::PERM ? ((R & ~31) + perm32(R & 31)) : R; sC[i] = C * 2; }
    const size_t kstep = (size_t)(BK * 2);
    const unsigned ldsw = (unsigned)wid * 1024u;
    const int aoff = lds_byte(wr * 64 + fr, fq * 8), boff = lds_byte(wc * 32 + fr, fq * 8);
#define PG8_SA(b, h) (((b) * 2 + (h)) * HTB)
#define PG8_SB(b, h) ((4 + (b) * 2 + (h)) * HTB)
#define PG8_STAGE(bufoff, gbase, voff) do { _Pragma("unroll") for (int _i = 0; _i < 2; ++_i) \
        __builtin_amdgcn_global_load_lds((const unsigned*)((const char*)(gbase) + (voff)[_i]), (LAS unsigned*)(lds + (bufoff) + ldsw + _i * 8192), 16, 0, 0); } while (0)
#define PG8_STAGEB(bufoff, gbase, voff) do { _Pragma("unroll") for (int _i = 0; _i < 2; ++_i) \
        __builtin_amdgcn_global_load_lds((const unsigned*)((const char*)(gbase) + (voff)[_i]), (LAS unsigned*)(lds + (bufoff) + ldsw + _i * 8192), 16, 0, P::BAUX); } while (0)
#define PG8_LD2(p_) __builtin_shufflevector(*(const LAS i32x4*)(p_), *(const LAS i32x4*)((p_) + 1024), 0, 1, 2, 3, 4, 5, 6, 7)
#define PG8_LDA(dst, b, h) do { _Pragma("unroll") for (int m = 0; m < 4; ++m) dst[m] = PG8_LD2(lds + PG8_SA(b, h) + aoff + m * 2048); } while (0)
#define PG8_LDB(dst, b, h) do { _Pragma("unroll") for (int n = 0; n < 2; ++n) dst[n] = PG8_LD2(lds + PG8_SB(b, h) + boff + n * 2048); } while (0)
#define PG8_LO(x) __builtin_bit_cast(bf16x8, __builtin_shufflevector((x), (x), 0, 1, 2, 3))
#define PG8_HI(x) __builtin_bit_cast(bf16x8, __builtin_shufflevector((x), (x), 4, 5, 6, 7))
#define PG8_MMA(ai, bj, At, Bt) do { __builtin_amdgcn_s_setprio(1); \
        if constexpr (P::F8) { _Pragma("unroll") for (int m = 0; m < 4; ++m) _Pragma("unroll") for (int n = 0; n < 2; ++n) \
            asm volatile("v_mfma_f32_16x16x128_f8f6f4 %0, %1, %2, %0" : "+v"(acc[ai][bj][m][n]) : "v"(Bt[n]), "v"(At[m])); }   \
        else { _Pragma("unroll") for (int m = 0; m < 4; ++m) _Pragma("unroll") for (int n = 0; n < 2; ++n) { \
            acc[ai][bj][m][n] = __builtin_amdgcn_mfma_f32_16x16x32_bf16(PG8_LO(Bt[n]), PG8_LO(At[m]), acc[ai][bj][m][n], 0, 0, 0); \
            acc[ai][bj][m][n] = __builtin_amdgcn_mfma_f32_16x16x32_bf16(PG8_HI(Bt[n]), PG8_HI(At[m]), acc[ai][bj][m][n], 0, 0, 0); } } \
        __builtin_amdgcn_s_setprio(0); } while (0)
#define PG8_WAIT_V(n) asm volatile("s_waitcnt vmcnt(" #n ")" ::: "memory")
#define PG8_WAIT_L(n) asm volatile("s_waitcnt lgkmcnt(" #n ")" ::: "memory")
#define PG8_BAR __builtin_amdgcn_s_barrier()
#define PG8_SCHED __builtin_amdgcn_sched_barrier(0)
#define PG8_ZERO() do { _Pragma("unroll") for (int a = 0; a < 2; ++a) _Pragma("unroll") for (int b = 0; b < 2; ++b) _Pragma("unroll") for (int m = 0; m < 4; ++m) _Pragma("unroll") for (int n = 0; n < 2; ++n) acc[a][b][m][n] = (f32x4){0.f, 0.f, 0.f, 0.f}; } while (0)
    GUnit cur, nxt; int ui = 0;
    if (!S.next(0, cur)) return;
    f32x4 acc[2][2][4][2];
    PG8_ZERO();
    i32x8 At[4], B0[2], B1[2];
    unsigned oaC[2], obC[2], oaN[2], obN[2], oaC1[2], oaN1[2];
    unsigned lda2 = P::VARP ? cur.lda2 : P::LDA2, ldb2 = P::VARP ? cur.ldb2 : P::LDB2;
#pragma unroll
    for (int i = 0; i < 2; ++i) { oaC[i] = (unsigned)sRA[i] * lda2 + (unsigned)sC[i]; obC[i] = (unsigned)sRB[i] * ldb2 + (unsigned)sC[i]; oaN[i] = oaC[i]; obN[i] = obC[i]; oaC1[i] = oaC[i]; oaN1[i] = oaC[i]; }
    if constexpr (P::GATHER) {
#pragma unroll
        for (int i = 0; i < 2; ++i) { oaC[i] = (unsigned)S.arow(cur, sRA[i]) * lda2 + (unsigned)sC[i]; oaC1[i] = (unsigned)S.arow(cur, ((P::HALFU && cur.hm) ? 0 : HALF) + sRA[i]) * lda2 + (unsigned)sC[i]; } }
    const char* cA = cur.A; const char* cB = cur.B; size_t hA = (P::GATHER || (P::HALFU && cur.hm)) ? (size_t)0 : (size_t)HALF * lda2, hB = (size_t)HALF * ldb2;
    if constexpr (P::HOOK) S.a_ready(cur, wid, lane);
    PG8_STAGEB(PG8_SB(0, 0), cB, obC); PG8_STAGE(PG8_SA(0, 0), cA, oaC); PG8_STAGEB(PG8_SB(0, 1), cB + hB, obC); PG8_STAGE(PG8_SA(0, 1), cA + hA, oaC1);
    if (wr == 1) PG8_BAR;
    PG8_WAIT_V(4); PG8_BAR;
    PG8_STAGEB(PG8_SB(1, 0), cB + kstep, obC); PG8_STAGE(PG8_SA(1, 0), cA + kstep, oaC); PG8_STAGEB(PG8_SB(1, 1), cB + hB + kstep, obC);
    PG8_WAIT_V(6); PG8_BAR;
    for (;;) {
        const bool has_next = S.next(ui + 1, nxt);
        const char* nA = has_next ? nxt.A : cA; const char* nB = has_next ? nxt.B : cB; size_t hAn = hA, hBn = hB;
        if constexpr (P::HALFU && !P::GATHER) { if (has_next) hAn = nxt.hm ? (size_t)0 : (size_t)HALF * lda2; }
        const bool hf = P::HALFU && cur.hm != 0;
        if constexpr (P::VARP) {
#pragma unroll
            for (int i = 0; i < 2; ++i) { oaN[i] = oaC[i]; obN[i] = obC[i]; }
            if (has_next) { hAn = (size_t)HALF * nxt.lda2; hBn = (size_t)HALF * nxt.ldb2;
#pragma unroll
                for (int i = 0; i < 2; ++i) { oaN[i] = (unsigned)sRA[i] * nxt.lda2 + (unsigned)sC[i]; obN[i] = (unsigned)sRB[i] * nxt.ldb2 + (unsigned)sC[i]; } } }
        if constexpr (P::GATHER) {
#pragma unroll
            for (int i = 0; i < 2; ++i) { oaN[i] = oaC[i]; oaN1[i] = oaC1[i]; }
            if (has_next) {
#pragma unroll
                for (int i = 0; i < 2; ++i) { oaN[i] = (unsigned)S.arow(nxt, sRA[i]) * lda2 + (unsigned)sC[i]; oaN1[i] = (unsigned)S.arow(nxt, ((P::HALFU && nxt.hm) ? 0 : HALF) + sRA[i]) * lda2 + (unsigned)sC[i]; } } }
        const int nt = P::VARP ? cur.nt : P::NT;
        for (int seg = 0; seg < (P::MID > 0 ? 2 : 1); ++seg) {
        const int t_lo = (P::MID > 0 && seg == 1) ? P::MID : 0, t_hi = (P::MID > 0 && seg == 0) ? P::MID : nt;
        for (int t = t_lo; t < t_hi; t += 2) {
            const bool last = (t == nt - 2);
            if constexpr (P::HOOK) { if (last && has_next) S.a_ready(nxt, wid, lane); }
            const char* a1 = cA + (size_t)(t + 1) * kstep;
            const char* a2 = last ? nA : cA + (size_t)(t + 2) * kstep; const char* b2 = last ? nB : cB + (size_t)(t + 2) * kstep;
            const char* a3 = a2 + kstep; const char* b3 = b2 + kstep;
            size_t h2A = hA, h2B = hB; unsigned oa2[2], ob2[2];
            if constexpr (P::HALFU) h2A = last ? hAn : hA;
#pragma unroll
            for (int i = 0; i < 2; ++i) { oa2[i] = oaC[i]; ob2[i] = obC[i]; }
            unsigned oa21[2];
#pragma unroll
            for (int i = 0; i < 2; ++i) oa21[i] = oa2[i];
            if constexpr (P::VARP) { h2A = last ? hAn : hA; h2B = last ? hBn : hB;
#pragma unroll
                for (int i = 0; i < 2; ++i) { oa2[i] = last ? oaN[i] : oaC[i]; ob2[i] = last ? obN[i] : obC[i]; oa21[i] = oa2[i]; } }
            if constexpr (P::GATHER) {
#pragma unroll
                for (int i = 0; i < 2; ++i) { oa2[i] = last ? oaN[i] : oaC[i]; oa21[i] = last ? oaN1[i] : oaC1[i]; } }
            PG8_LDB(B0, 0, 0); PG8_SCHED; PG8_LDA(At, 0, 0); PG8_STAGE(PG8_SA(1, 1), a1 + hA, oaC1);
            PG8_WAIT_L(8); PG8_BAR; PG8_WAIT_L(0); PG8_MMA(0, 0, At, B0); PG8_BAR; PG8_SCHED;
            PG8_LDB(B1, 0, 1); PG8_STAGEB(PG8_SB(0, 0), b2, ob2);
            PG8_BAR; PG8_WAIT_L(0); PG8_MMA(0, 1, At, B1); PG8_BAR;
            if (!hf) PG8_LDA(At, 0, 1); PG8_STAGE(PG8_SA(0, 0), a2, oa2);
            PG8_BAR; PG8_WAIT_L(0); if (!hf) PG8_MMA(1, 0, At, B0); PG8_BAR; PG8_SCHED;
            PG8_STAGEB(PG8_SB(0, 1), b2 + h2B, ob2);
            PG8_WAIT_V(6); PG8_BAR; if (!hf) PG8_MMA(1, 1, At, B1); PG8_BAR;
            PG8_LDB(B0, 1, 0); PG8_SCHED; PG8_LDA(At, 1, 0); PG8_STAGE(PG8_SA(0, 1), a2 + h2A, oa21);
            PG8_WAIT_L(8); PG8_BAR; PG8_WAIT_L(0); PG8_MMA(0, 0, At, B0); PG8_BAR; PG8_SCHED;
            PG8_LDB(B1, 1, 1); PG8_STAGEB(PG8_SB(1, 0), b3, ob2);
            PG8_BAR; PG8_WAIT_L(0); PG8_MMA(0, 1, At, B1); PG8_BAR;
            if (!hf) PG8_LDA(At, 1, 1); PG8_STAGE(PG8_SA(1, 0), a3, oa2);
            PG8_BAR; PG8_WAIT_L(0); if (!hf) PG8_MMA(1, 0, At, B0); PG8_BAR; PG8_SCHED;
            PG8_STAGEB(PG8_SB(1, 1), b3 + h2B, ob2);
            PG8_WAIT_V(6); PG8_BAR; if (!hf) PG8_MMA(1, 1, At, B1); PG8_BAR;
        }
        if constexpr (P::MID > 0) { if (seg == 0) { if constexpr (P::F8) asm volatile("s_nop 15\n\ts_nop 15" ::: "memory"); int fr2 = fr, fq2 = fq; asm volatile("" : "+v"(fr2), "+v"(fq2)); S.mid(acc, cur, wr, wc, fr2, fq2); } }
        }
        if constexpr (P::ALIGN) { if (wr == 0) PG8_BAR; }
        if constexpr (P::F8) asm volatile("s_nop 15\n\ts_nop 15" ::: "memory");
        int fr2 = fr, fq2 = fq; asm volatile("" : "+v"(fr2), "+v"(fq2));
        const bool z = S.epi(acc, cur, wr, wc, fr2, fq2);
        if (!has_next) break;
        if (z) PG8_ZERO();
        cur = nxt; cA = nA; cB = nB;
        if constexpr (P::VARP) { hA = hAn; hB = hBn;
#pragma unroll
            for (int i = 0; i < 2; ++i) { oaC[i] = oaN[i]; obC[i] = obN[i]; } }
        if constexpr (P::HALFU) hA = hAn;
        if constexpr (P::GATHER) {
#pragma unroll
            for (int i = 0; i < 2; ++i) { oaC[i] = oaN[i]; oaC1[i] = oaN1[i]; } }
        ++ui;
        if constexpr (P::ALIGN) { if (wr == 1) PG8_BAR; }
    }
    PG8_WAIT_V(0);
    if constexpr (!P::ALIGN) { if (wr == 0) PG8_BAR; }
    PG8_BAR;
#undef PG8_SA
#undef PG8_SB
#undef PG8_STAGE
#undef PG8_STAGEB
#undef PG8_LDA
#undef PG8_LDB
#undef PG8_MMA
#undef PG8_LD2
#undef PG8_LO
#undef PG8_HI
#undef PG8_WAIT_V
#undef PG8_WAIT_L
#undef PG8_BAR
#undef PG8_SCHED
#undef PG8_ZERO
}
}
using pg8::GUnit;

struct ProbInProj {
    static constexpr int BAUX = 0; static constexpr bool HALFU = HALF_UNITS != 0; static constexpr bool HOOK = false; static constexpr bool GATHER = false; static constexpr bool ALIGN = true; static constexpr bool F8 = F8_IN; static constexpr int EB = F8 ? 1 : 2;
    static constexpr int MID = 0; static constexpr bool PERM = true, VARP = false; static constexpr unsigned LDA2 = D * EB, LDB2 = D * EB; static constexpr int NT = D * EB / 128;
    const u16* A; const u16* Bt; int G, c;
    unsigned char* ws; float* gkl; const float* tab;
    __device__ __forceinline__ bool next(int i, GUnit& u) const {
        constexpr int nM = T / 256, nN = NWIN / 256, nwg = nM * nN;
        int L, hm; if (!pg8::deal(i, c, G, nwg, HALFU, L, hm)) return false;
        int pm, pn; pg8::tile_of(pg8::xcd_remap(L, nwg), nM, nN, pm, pn);
        u.A = (const char*)A + ((size_t)pm * 256 + (hm == 2 ? 128 : 0)) * D * EB; u.B = (const char*)Bt + (size_t)pn * 256 * D * EB; u.lda2 = LDA2; u.ldb2 = LDB2; u.nt = NT; u.pm = pm; u.pn = pn; u.aux = 0; u.hm = hm;
        return true;
    }
    __device__ __forceinline__ bool epi(f32x4 (&acc)[2][2][4][2], const GUnit& u, int wr, int wc, int fr, int fq) const {
#ifdef PROBE_DOUBLEK
        if (u.aux == 0) return false;
#pragma unroll
        for (int ai = 0; ai < 2; ++ai)
#pragma unroll
            for (int bj = 0; bj < 2; ++bj)
#pragma unroll
                for (int m = 0; m < 4; ++m)
#pragma unroll
                    for (int n = 0; n < 2; ++n) acc[ai][bj][m][n] = acc[ai][bj][m][n] * 0.5f;
#endif
        if constexpr (F8) {
#pragma unroll
            for (int ai = 0; ai < 2; ++ai)
#pragma unroll
                for (int bj = 0; bj < 2; ++bj)
#pragma unroll
                    for (int m = 0; m < 4; ++m)
#pragma unroll
                        for (int n = 0; n < 2; ++n) acc[ai][bj][m][n] = acc[ai][bj][m][n] * F8_INV; }
        const int pn = u.pn; int mode, ld, colt; size_t boff;
        if (pn < 18) { const int q = pn / 6; boff = P_QA + (size_t)q * (P_KA - P_QA); ld = 1536; colt = 256 * (pn - 6 * q); mode = q == 0 ? 1 : (q == 1 ? 2 : 0); }
        else if (pn < 26) { const int q = (pn - 18) / 4; boff = P_QB + (size_t)q * (P_KB - P_QB); ld = 1024; colt = 256 * ((pn - 18) - 4 * q); mode = 0; }
        else if (pn < 58) { const int q = (pn - 26) / 8; boff = P_VB + (size_t)q * (P_RB - P_VB); ld = 2048; colt = 256 * ((pn - 26) - 8 * q); mode = q == 0 ? 0 : (q == 1 ? 3 : 4); }
        else { boff = P_QA; ld = 0; colt = 0; mode = 5; }
        u16* base = (u16*)(ws + boff);
        const __amdgpu_buffer_rsrc_t rs = __builtin_amdgcn_make_buffer_rsrc(ws, 0, (int)0x7fffffff, 0x00020000);
        const int row0 = u.pm * 256 + (u.hm == 2 ? 128 : 0) + wr * 64 + fr, cl = wc * 32 + 8 * fq; const int nai = u.hm ? 1 : 2;
        if (mode == 5) {
            if (wc == 0 && fq < 2) {
#pragma unroll
                for (int ai = 0; ai < 2; ++ai) if (ai < nai)
#pragma unroll
                    for (int m = 0; m < 4; ++m) { float* g = gkl + (size_t)(row0 + ai * 128 + m * 16) * 16 + 8 * fq; *(f32x4*)g = acc[ai][0][m][0]; *(f32x4*)(g + 4) = acc[ai][0][m][1]; } }
            return true; }
        const bool rope = (mode == 1 || mode == 2) && wc == 0;
        const float sgn = fq < 2 ? -1.f : 1.f;
#pragma unroll
        for (int ai = 0; ai < 2; ++ai) { if (ai >= nai) break;
            f32x4 tb[4][4];
            if (rope) {
#pragma unroll
                for (int m = 0; m < 4; ++m) { const f32x4* tp = (const f32x4*)(tab + ((size_t)(row0 + ai * 128 + m * 16) * 16 + 8 * (fq & 1)) * 2); tb[m][0] = tp[0]; tb[m][1] = tp[1]; tb[m][2] = tp[2]; tb[m][3] = tp[3]; }
                asm volatile("" ::: "memory"); }
#pragma unroll
            for (int m = 0; m < 4; ++m) { const int row = row0 + ai * 128 + m * 16; u16* rowp = base + (size_t)row * ld + colt + cl;
#pragma unroll
                for (int bj = 0; bj < 2; ++bj) { f32x4 v0 = acc[ai][bj][m][0], v1 = acc[ai][bj][m][1];
                    if (rope) { const f32x4 t0 = tb[m][0], t1 = tb[m][1], t2 = tb[m][2], t3 = tb[m][3]; f32x4 o0, o1;
#pragma unroll
                        for (int j = 0; j < 4; ++j) { o0[j] = sgn * __shfl_xor(v0[j], 32); o1[j] = sgn * __shfl_xor(v1[j], 32); }
                        v0 = (f32x4){v0[0] * t0[0] + o0[0] * t0[1], v0[1] * t0[2] + o0[1] * t0[3], v0[2] * t1[0] + o0[2] * t1[1], v0[3] * t1[2] + o0[3] * t1[3]};
                        v1 = (f32x4){v1[0] * t2[0] + o1[0] * t2[1], v1[1] * t2[2] + o1[1] * t2[3], v1[2] * t3[0] + o1[2] * t3[1], v1[3] * t3[2] + o1[3] * t3[3]}; }
                    if (mode == 1) { v0 = v0 * 0.08838834764831845f; v1 = v1 * 0.08838834764831845f; }
                    if (mode == 3) {
#pragma unroll
                        for (int j = 0; j < 4; ++j) { v0[j] = v0[j] * fsigmoid(v0[j]); v1[j] = v1[j] * fsigmoid(v1[j]); } }
                    if (mode == 4) {
#pragma unroll
                        for (int j = 0; j < 4; ++j) { v0[j] = fsigmoid(v0[j]); v1[j] = fsigmoid(v1[j]); } }
                    u32x4 w; w.x = cvtpk(v0[0], v0[1]); w.y = cvtpk(v0[2], v0[3]); w.z = cvtpk(v1[0], v1[1]); w.w = cvtpk(v1[2], v1[3]);
                    if (WT_STORES) __builtin_amdgcn_raw_buffer_store_b128(w, rs, (unsigned)(boff + ((size_t)row * ld + colt + cl + bj * 128) * 2), 0, 16); else *(u32x4*)(rowp + bj * 128) = w; } }
            asm volatile("" ::: "memory"); }
        return true;
    }
};
struct ProbMerge {
    static constexpr int BAUX = 0; static constexpr bool HALFU = false; static constexpr bool HOOK = false; static constexpr bool GATHER = false; static constexpr bool ALIGN = false; static constexpr bool F8 = (USE_F8 & 8) != 0; static constexpr int EB = F8 ? 1 : 2; static constexpr int MID = 512 * EB / 128; static constexpr bool PERM = true, VARP = false; static constexpr unsigned LDA2 = KAB * EB, LDB2 = KAB * EB; static constexpr int NT = KAB * EB / 128;
    const u16 *yab, *PabT, *Ga, *Gb; u16* mrg; int G, c;
    __device__ __forceinline__ bool next(int i, GUnit& u) const {
        constexpr int nM = T / 256, nN = D / 256, nwg = nM * nN;
        const long L = (long)i * G + c; if (L >= nwg) return false;
        int pm, pn; pg8::tile_of<4>(pg8::xcd_remap((int)L, nwg), nM, nN, pm, pn); u.pm = pm; u.pn = pn; u.aux = 0;
        u.A = (const char*)yab + (size_t)pm * 256 * KAB * EB; u.B = (const char*)PabT + (size_t)pn * 256 * KAB * EB; u.lda2 = LDA2; u.ldb2 = LDB2; u.nt = NT; u.hm = 0; return true;
    }
    __device__ __forceinline__ void mid(f32x4 (&acc)[2][2][4][2], const GUnit& u, int wr, int wc, int fr, int fq) const {
        const int row0 = u.pm * 256 + wr * 64 + fr, col0 = u.pn * 256 + wc * 32 + 8 * fq;
#pragma unroll
        for (int ai = 0; ai < 2; ++ai) {
            u32x4 gav[4][2], gbv[4][2];
#pragma unroll
            for (int m = 0; m < 4; ++m) { const size_t ro = (size_t)(row0 + ai * 128 + m * 16) * D + col0;
#pragma unroll
                for (int bj = 0; bj < 2; ++bj) { gbv[m][bj] = *(const u32x4*)(Gb + ro + bj * 128); gav[m][bj] = *(const u32x4*)(Ga + ro + bj * 128); } }
            asm volatile("" ::: "memory");
#pragma unroll
            for (int m = 0; m < 4; ++m)
#pragma unroll
                for (int bj = 0; bj < 2; ++bj) { const u32x4 gb = gbv[m][bj], ga = gav[m][bj];
                    const float b[8] = {bflo(gb.x), bfhi(gb.x), bflo(gb.y), bfhi(gb.y), bflo(gb.z), bfhi(gb.z), bflo(gb.w), bfhi(gb.w)};
                    const float a[8] = {bflo(ga.x), bfhi(ga.x), bflo(ga.y), bfhi(ga.y), bflo(ga.z), bfhi(ga.z), bflo(ga.w), bfhi(ga.w)};
#pragma unroll
                    for (int j = 0; j < 4; ++j) { acc[ai][bj][m][0][j] *= a[j] * __builtin_amdgcn_rcpf(b[j]); acc[ai][bj][m][1][j] *= a[4 + j] * __builtin_amdgcn_rcpf(b[4 + j]); } }
            asm volatile("" ::: "memory"); }
    }
    __device__ __forceinline__ bool epi(f32x4 (&acc)[2][2][4][2], const GUnit& u, int wr, int wc, int fr, int fq) const {
        const int row0 = u.pm * 256 + wr * 64 + fr, col0 = u.pn * 256 + wc * 32 + 8 * fq;
        u32x4 gball[2][4][2];
#pragma unroll
        for (int ai = 0; ai < 2; ++ai)
#pragma unroll
            for (int m = 0; m < 4; ++m) { const size_t ro = (size_t)(row0 + ai * 128 + m * 16) * D + col0;
#pragma unroll
                for (int bj = 0; bj < 2; ++bj) gball[ai][m][bj] = *(const u32x4*)(Gb + ro + bj * 128); }
        asm volatile("" ::: "memory");
#pragma unroll
        for (int ai = 0; ai < 2; ++ai) {
#pragma unroll
            for (int m = 0; m < 4; ++m) { const size_t ro = (size_t)(row0 + ai * 128 + m * 16) * D + col0;
#pragma unroll
                for (int bj = 0; bj < 2; ++bj) { const u32x4 gb = gball[ai][m][bj];
                    const float b[8] = {bflo(gb.x), bfhi(gb.x), bflo(gb.y), bfhi(gb.y), bflo(gb.z), bfhi(gb.z), bflo(gb.w), bfhi(gb.w)};
                    const f32x4 v0 = acc[ai][bj][m][0], v1 = acc[ai][bj][m][1];
                    if (F8_WO) { constexpr float sc = F8_ACT * (F8 ? F8_INV : 1.f); u32x2 w8; w8.x = cvt4_f8(v0[0] * b[0] * sc, v0[1] * b[1] * sc, v0[2] * b[2] * sc, v0[3] * b[3] * sc); w8.y = cvt4_f8(v1[0] * b[4] * sc, v1[1] * b[5] * sc, v1[2] * b[6] * sc, v1[3] * b[7] * sc);
                        *(u32x2*)((unsigned char*)mrg + ro + bj * 128) = w8; }
                    else { constexpr float sc = F8 ? F8_INV : 1.f; u32x4 w; w.x = cvtpk(v0[0] * b[0] * sc, v0[1] * b[1] * sc); w.y = cvtpk(v0[2] * b[2] * sc, v0[3] * b[3] * sc); w.z = cvtpk(v1[0] * b[4] * sc, v1[1] * b[5] * sc); w.w = cvtpk(v1[2] * b[6] * sc, v1[3] * b[7] * sc);
                        *(u32x4*)(mrg + ro + bj * 128) = w; } } }
            asm volatile("" ::: "memory"); }
        return true;
    }
};
struct ProbWo {
    static constexpr int BAUX = 0; static constexpr bool HALFU = false; static constexpr bool HOOK = false; static constexpr bool GATHER = false; static constexpr bool ALIGN = false; static constexpr bool F8 = (USE_F8 & 4) != 0; static constexpr int EB = F8 ? 1 : 2; static constexpr int MID = 0; static constexpr bool PERM = false, VARP = false; static constexpr unsigned LDA2 = D * EB, LDB2 = D * EB; static constexpr int NT = D * EB / 128;
    const u16 *A, *Bt; const void* hres; u16* pre1; int hres_bf16; int G, c;
    __device__ __forceinline__ bool next(int i, GUnit& u) const {
        constexpr int nM = T / 256, nN = D / 256, nwg = nM * nN;
        const long L = (long)i * G + c; if (L >= nwg) return false;
        int pm, pn; pg8::tile_of<4>(pg8::xcd_remap((int)L, nwg), nM, nN, pm, pn);
        u.A = (const char*)A + (size_t)pm * 256 * D * EB; u.B = (const char*)Bt + (size_t)pn * 256 * D * EB; u.lda2 = LDA2; u.ldb2 = LDB2; u.nt = NT; u.pm = pm; u.pn = pn; u.aux = 0; u.hm = 0; return true;
    }
    __device__ __forceinline__ bool epi(f32x4 (&acc)[2][2][4][2], const GUnit& u, int wr, int wc, int fr, int fq) const {
        const int row0 = u.pm * 256 + wr * 64 + fr, col0 = u.pn * 256 + wc * 32 + 4 * fq;
#pragma unroll
        for (int ai = 0; ai < 2; ++ai) {
            f32x4 hv[4][2][2];
            if (hres_bf16) {
#pragma unroll
                for (int m = 0; m < 4; ++m) { const size_t ro = (size_t)(row0 + ai * 128 + m * 16) * D + col0;
#pragma unroll
                    for (int bj = 0; bj < 2; ++bj)
#pragma unroll
                        for (int n = 0; n < 2; ++n) { const u32x2 q = *(const u32x2*)((const u16*)hres + ro + bj * 128 + n * 16); hv[m][bj][n] = (f32x4){bflo(q.x), bfhi(q.x), bflo(q.y), bfhi(q.y)}; } } }
            else {
#pragma unroll
                for (int m = 0; m < 4; ++m) { const size_t ro = (size_t)(row0 + ai * 128 + m * 16) * D + col0;
#pragma unroll
                    for (int bj = 0; bj < 2; ++bj)
#pragma unroll
                        for (int n = 0; n < 2; ++n) hv[m][bj][n] = *(const f32x4*)((const float*)hres + ro + bj * 128 + n * 16); } }
            asm volatile("" ::: "memory");
#pragma unroll
            for (int m = 0; m < 4; ++m) { const size_t ro = (size_t)(row0 + ai * 128 + m * 16) * D + col0;
#pragma unroll
                for (int bj = 0; bj < 2; ++bj)
#pragma unroll
                    for (int n = 0; n < 2; ++n) { const f32x4 o = hv[m][bj][n] * DN_ALPHA + acc[ai][bj][m][n] * (F8 ? F8_INV : 1.f); u32x2 w; w.x = cvtpk(o[0], o[1]); w.y = cvtpk(o[2], o[3]); *(u32x2*)(pre1 + ro + bj * 128 + n * 16) = w; } }
            asm volatile("" ::: "memory"); }
        return true;
    }
};
__device__ __forceinline__ int moe_cnt_load(const int* cnt, int lane) { int cv = 0; if (lane < 16) cv = __hip_atomic_load(cnt + 64 * lane, __ATOMIC_RELAXED, __HIP_MEMORY_SCOPE_AGENT); return cv; }
__device__ __forceinline__ int moe_npanels(int cv) { int s = (cv + 255) >> 8; s += __shfl_xor(s, 1); s += __shfl_xor(s, 2); s += __shfl_xor(s, 4); s += __shfl_xor(s, 8); return __builtin_amdgcn_readfirstlane(s); }
__device__ __forceinline__ void moe_prefix_cv(int cv, int lane, int (&pre)[17], int (&cn)[16]) {
    int s = (cv + 255) >> 8;
#pragma unroll
    for (int o = 1; o < 16; o <<= 1) { const int t = __shfl_up(s, o); if (lane >= o) s += t; }
    pre[0] = 0;
#pragma unroll
    for (int e = 0; e < 16; ++e) { pre[e + 1] = __builtin_amdgcn_readlane(s, e); cn[e] = __builtin_amdgcn_readlane(cv, e); }
}
__device__ __forceinline__ void moe_prefix(const int* cnt, int lane, int (&pre)[17], int (&cn)[16]) { moe_prefix_cv(moe_cnt_load(cnt, lane), lane, pre, cn); }
template <int NT>
__device__ __forceinline__ void moe_decode(const int (&pre)[17], int L, int& e, int& j, int& prow) {
    int ee = 0;
#pragma unroll
    for (int k = 1; k < 16; ++k) ee += (L >= pre[k] * NT) ? 1 : 0;
    int pb = 0, np = 1;
#pragma unroll
    for (int k = 0; k < 16; ++k) { if (ee == k) { pb = pre[k]; np = pre[k + 1] - pre[k]; } }
    const int rem = L - pb * NT; e = ee; j = rem / np; prow = pb + (rem % np);
}
constexpr int ACTP = F8_MOE ? 1536 : DFF;
struct ProbGateUp {
    static constexpr int BAUX = BAUX_MOE; static constexpr bool HALFU = HALF_UNITS != 0; static constexpr bool HOOK = false; static constexpr bool GATHER = true; static constexpr bool ALIGN = true; static constexpr bool F8 = F8_MOE; static constexpr int EB = F8 ? 1 : 2;
    static constexpr int MID = 0; static constexpr bool PERM = true, VARP = false; static constexpr unsigned LDA2 = D * EB, LDB2 = D * EB; static constexpr int NT = D * EB / 128;
    const u16 *Xg, *Wgu; u16* act; const int* tok; unsigned* pcnt; int pre[17]; int G, c;
    __device__ __forceinline__ bool next(int i, GUnit& u) const {
        const int nwg = pre[16] * 11; int L, hm; if (!pg8::deal(i, c, G, nwg, HALFU, L, hm)) return false;
        int e, j, prow; moe_decode<11>(pre, pg8::xcd_remap(L, nwg), e, j, prow);
        int pb = 0;
#pragma unroll
        for (int k = 0; k < 16; ++k) { if (e == k) pb = pre[k]; }
        u.A = (const char*)Xg; u.B = (const char*)Wgu + ((size_t)e * 2816 + (size_t)j * 256) * D * EB; u.lda2 = (unsigned)(e * 8192 + (prow - pb) * 256 + (hm == 2 ? 128 : 0)); u.ldb2 = LDB2; u.nt = NT; u.pm = prow; u.pn = j; u.aux = e; u.hm = hm; return true;
    }
    __device__ __forceinline__ int arow(const GUnit& u, int r) const { return tok[u.lda2 + r]; }
    __device__ __forceinline__ bool epi(f32x4 (&acc)[2][2][4][2], const GUnit& u, int wr, int wc, int fr, int fq) const {
        const int row0 = u.pm * 256 + (u.hm == 2 ? 128 : 0) + wr * 64 + fr, col0 = u.pn * 128 + wc * 32 + 8 * fq; const int nai = u.hm ? 1 : 2;
#pragma unroll
        for (int ai = 0; ai < 2; ++ai) if (ai < nai)
#pragma unroll
            for (int m = 0; m < 4; ++m) { const f32x4 g0 = acc[ai][0][m][0], g1 = acc[ai][0][m][1], u0 = acc[ai][1][m][0], u1 = acc[ai][1][m][1]; f32x4 r0, r1;
#pragma unroll
                for (int j = 0; j < 4; ++j) { const float ga = g0[j] * (F8 ? F8_INV : 1.f), gb = g1[j] * (F8 ? F8_INV : 1.f); r0[j] = ga * fsigmoid(ga) * (u0[j] * (F8 ? F8_INV : 1.f)); r1[j] = gb * fsigmoid(gb) * (u1[j] * (F8 ? F8_INV : 1.f)); }
                if constexpr (F8) { unsigned char* ap = (unsigned char*)act + (size_t)(row0 + ai * 128 + m * 16) * ACTP;
                    u32x2 w; w.x = cvt4_f8(r0[0] * F8_ACT, r0[1] * F8_ACT, r0[2] * F8_ACT, r0[3] * F8_ACT); w.y = cvt4_f8(r1[0] * F8_ACT, r1[1] * F8_ACT, r1[2] * F8_ACT, r1[3] * F8_ACT);
                    if (MOE_CHAIN) { __hip_atomic_store((unsigned long long*)(ap + col0), (unsigned long long)w.x | ((unsigned long long)w.y << 32), __ATOMIC_RELAXED, __HIP_MEMORY_SCOPE_AGENT);
                        if (u.pn == 10) __hip_atomic_store((unsigned long long*)(ap + DFF + wc * 32 + 8 * fq), 0ull, __ATOMIC_RELAXED, __HIP_MEMORY_SCOPE_AGENT); }
                    else { *(u32x2*)(ap + col0) = w;
                        if (u.pn == 10) { unsigned z0 = 0u; asm volatile("" : "+v"(z0)); *(u32x2*)(ap + DFF + wc * 32 + 8 * fq) = (u32x2){z0, z0}; } } }
                else { u32x4 w; w.x = cvtpk(r0[0], r0[1]); w.y = cvtpk(r0[2], r0[3]); w.z = cvtpk(r1[0], r1[1]); w.w = cvtpk(r1[2], r1[3]);
                    *(u32x4*)(act + (size_t)(row0 + ai * 128 + m * 16) * DFF + col0) = w; } }
        if (MOE_CHAIN) { asm volatile("s_waitcnt vmcnt(0)" ::: "memory");
            if (fr == 0 && fq == 0) __hip_atomic_fetch_add(pcnt + 64 * u.pm, 1u, __ATOMIC_RELAXED, __HIP_MEMORY_SCOPE_AGENT); }
        return true;
    }
};
struct ProbDown {
    static constexpr int BAUX = BAUX_MOE; static constexpr bool HALFU = HALF_UNITS != 0; static constexpr bool HOOK = MOE_CHAIN != 0; static constexpr bool GATHER = false; static constexpr bool ALIGN = true; static constexpr bool F8 = F8_MOE; static constexpr int EB = F8 ? 1 : 2;
    static constexpr int MID = 0; static constexpr bool PERM = true, VARP = false; static constexpr unsigned LDA2 = ACTP * EB, LDB2 = ACTP * EB; static constexpr int NT = ACTP * EB / 128;
    const u16 *act, *Wd; u16* dn; unsigned* pcnt; unsigned* tmo; int pre[17]; int G, c;
    __device__ __forceinline__ bool next(int i, GUnit& u) const {
        const int nwg = pre[16] * 8; int L, hm; if (!pg8::deal(i, MOE_CHAIN ? G - 1 - c : c, G, nwg, HALFU, L, hm)) return false;
        int e, j, prow; moe_decode<8>(pre, pg8::xcd_remap(L, nwg), e, j, prow);
        u.A = (const char*)act + ((size_t)prow * 256 + (hm == 2 ? 128 : 0)) * ACTP * EB; u.B = (const char*)Wd + ((size_t)e * D + (size_t)j * 256) * ACTP * EB; u.lda2 = LDA2; u.ldb2 = LDB2; u.nt = NT; u.pm = prow; u.pn = j; u.aux = e; u.hm = hm; return true;
    }
    __device__ __forceinline__ void a_ready(const GUnit& u, int wid, int lane) const {
        if (wid == 0) { unsigned polls = 0;
            while ((unsigned)__builtin_amdgcn_readfirstlane(__hip_atomic_load(pcnt + 64 * u.pm, __ATOMIC_RELAXED, __HIP_MEMORY_SCOPE_AGENT)) < 88u) {
                if (++polls > (1u << 22)) { if (lane == 0) __hip_atomic_store(tmo, 1u, __ATOMIC_RELAXED, __HIP_MEMORY_SCOPE_AGENT); break; }
                __builtin_amdgcn_s_sleep(2); }
            __builtin_amdgcn_fence(__ATOMIC_ACQUIRE, "agent");
            asm volatile("s_waitcnt vmcnt(0)" ::: "memory"); }
        asm volatile("" ::: "memory"); __builtin_amdgcn_s_barrier(); asm volatile("" ::: "memory");
    }
    __device__ __forceinline__ bool epi(f32x4 (&acc)[2][2][4][2], const GUnit& u, int wr, int wc, int fr, int fq) const {
        const int row0 = u.pm * 256 + (u.hm == 2 ? 128 : 0) + wr * 64 + fr, col0 = u.pn * 256 + wc * 32 + 8 * fq; const int nai = u.hm ? 1 : 2;
#pragma unroll
        for (int ai = 0; ai < 2; ++ai) if (ai < nai)
#pragma unroll
            for (int m = 0; m < 4; ++m) { u16* rowp = dn + (size_t)(row0 + ai * 128 + m * 16) * D + col0;
#pragma unroll
                for (int bj = 0; bj < 2; ++bj) { const f32x4 v0 = acc[ai][bj][m][0] * (F8 ? F8_INV : 1.f), v1 = acc[ai][bj][m][1] * (F8 ? F8_INV : 1.f);
                    if (DN_F8) { u32x2 w8; w8.x = cvt4_f8(v0[0] * 16.f, v0[1] * 16.f, v0[2] * 16.f, v0[3] * 16.f); w8.y = cvt4_f8(v1[0] * 16.f, v1[1] * 16.f, v1[2] * 16.f, v1[3] * 16.f);
                        *(u32x2*)((unsigned char*)dn + (size_t)(row0 + ai * 128 + m * 16) * D + col0 + bj * 128) = w8; }
                    else { u32x4 w; w.x = cvtpk(v0[0], v0[1]); w.y = cvtpk(v0[2], v0[3]); w.z = cvtpk(v1[0], v1[1]); w.w = cvtpk(v1[2], v1[3]);
                        *(u32x4*)(rowp + bj * 128) = w; } } }
        return true;
    }
};

#define XB_TMO      128
#define XB_XCNT(j)  (256  + 64 * (j))
#define XB_XSUB(j)  (1280 + 64 * (j))
#define XB_XGEN(j)  (2304 + 64 * (j))
#define XB_TOP      3328
#define XB_TOPGEN   3392
#define XCD_BAR_WORDS 3456
#define XB_SPIN_CAP (1u << 18)
__device__ __forceinline__ unsigned xb_ld(unsigned* p)              { return __hip_atomic_load(p, __ATOMIC_RELAXED, __HIP_MEMORY_SCOPE_AGENT); }
__device__ __forceinline__ unsigned xb_add(unsigned* p, unsigned v) { return __hip_atomic_fetch_add(p, v, __ATOMIC_RELAXED, __HIP_MEMORY_SCOPE_AGENT); }
__device__ __forceinline__ unsigned xb_xcc_id() { return (unsigned)__builtin_amdgcn_s_getreg((3 << 11) | 20) & 0xFu; }
#define XB_SPIN(cond, bar) do { unsigned _sp = 0; while (cond) { __builtin_amdgcn_s_sleep(1); \
    if ((++_sp & 255u) == 0u) { if (xb_ld(&(bar)[XB_TMO])) break; if (_sp > XB_SPIN_CAP) { atomicAdd(&(bar)[XB_TMO], 1u); break; } } } } while (0)
struct XcdBarrier { unsigned* bar; unsigned x; volatile LAS unsigned* st; };
__device__ __forceinline__ XcdBarrier xcd_barrier_post(unsigned* bar, volatile LAS unsigned* st) {
    XcdBarrier b; b.bar = bar; b.x = xb_xcc_id(); b.st = st;
    if (threadIdx.x == 0) (void)xb_add(&bar[XB_XCNT(b.x)], 1u);
    return b;
}
__device__ __forceinline__ void xcd_barrier_complete(unsigned* bar, unsigned x, unsigned& nloc, unsigned& nx) {
    const unsigned G = gridDim.x * gridDim.y * gridDim.z;
    unsigned sum, cnt, mine, sp = 0u;
    for (;;) {
        sum = 0u; cnt = 0u; mine = 0u;
#pragma unroll
        for (unsigned j = 0; j < 16; ++j) { const unsigned c = xb_ld(&bar[XB_XCNT(j)]); sum += c; cnt += (c > 0u) ? 1u : 0u; mine = (j == x) ? c : mine; }
        if (sum == G) break;
        __builtin_amdgcn_s_sleep(1);
        if ((++sp & 255u) == 0u) { if (xb_ld(&bar[XB_TMO])) break; if (sp > XB_SPIN_CAP) { atomicAdd(&bar[XB_TMO], 1u); break; } }
    }
    nloc = mine > 0u ? mine : 1u; nx = cnt > 0u ? cnt : 1u;
}
__device__ __forceinline__ void xcd_barrier(const XcdBarrier& b, int wv) {
    asm volatile("s_waitcnt vmcnt(0)" ::: "memory");
    __syncthreads();
    if (wv == 0 && lane_id() == 0) {
        unsigned* bar = b.bar; asm volatile("" : "+s"(bar));
        __builtin_amdgcn_s_waitcnt(0);
        unsigned nloc = b.st[0], nx = b.st[1];
        if (nloc == 0u) { xcd_barrier_complete(bar, b.x, nloc, nx); b.st[0] = nloc; b.st[1] = nx; }
        const unsigned old = xb_add(&bar[XB_XSUB(b.x)], 1u);
        const unsigned gen = old / nloc;
        if (old + 1u == (gen + 1u) * nloc) {
            __builtin_amdgcn_fence(__ATOMIC_RELEASE, "agent");
            asm volatile("s_waitcnt vmcnt(0)" ::: "memory");
            const unsigned og = xb_add(&bar[XB_TOP], 1u);
            const unsigned tg = og / nx;
            if (og + 1u == (tg + 1u) * nx) xb_add(&bar[XB_TOPGEN], 1u);
            else XB_SPIN(xb_ld(&bar[XB_TOPGEN]) == tg, bar);
            __builtin_amdgcn_fence(__ATOMIC_ACQUIRE, "agent");
            xb_add(&bar[XB_XGEN(b.x)], 1u);
            asm volatile("s_waitcnt vmcnt(0)" ::: "memory");
        } else {
            XB_SPIN(xb_ld(&bar[XB_XGEN(b.x)]) == gen, bar);
            __builtin_amdgcn_fence(__ATOMIC_ACQUIRE, "agent");
            asm volatile("s_waitcnt vmcnt(0)" ::: "memory");
        }
    }
    __syncthreads();
}

struct Args {
    const float* x; const int* pos; const float* w_in; const float* w_gk2; const float* b_gk; const float* g_gla; const float* p_a; const float* p_b; const float* w_o;
    const float* ln1_g; const float* ln1_b; const float* router_w; const float* router_b; const float* w_gate; const float* w_up; const float* w_down; const float* ln2_g; const float* ln2_b;
    float* out; unsigned char* ws; int ph_lo, ph_hi;
};
constexpr int CW_PANEL = 16384  ;
constexpr int CW_TMO = 0, CW_CNT = 8192  , CW_BAR = 4096;
constexpr int NPH_LAYER = 11, NPH = 1 + 2 * NPH_LAYER;

struct TrItem { const float* src; unsigned char* dst; int ldn, N, ldd, k0, n0, mode, esz; };
static_assert(!(F8_MRG && GLA_SIMPLE), "the simple GLA path writes bf16 y_b");
constexpr int WEB_IN = F8_IN ? 1 : 2, WEB = F8_MOE ? 1 : 2, WEB_WO = F8_WO ? 1 : 2, WEB_MRG = F8_MRG ? 1 : 2;
__device__ __forceinline__ void tr_decode(const Args& a, int it, TrItem& q) {
    constexpr int NT_IN = (NIN + 63) / 64;
    constexpr int I_WIN = 32 * NT_IN, I_PA = 8 * 32, I_PB = 32 * 32, I_WO = 32 * 32, I_WG = NE * 32 * 22, I_WD = NE * 22 * 32, I_LAYER = I_WIN + I_PA + I_PB + I_WO + 2 * I_WG + I_WD;
    unsigned char* ws = a.ws; const int l = it / I_LAYER; int r = it % I_LAYER;
    if (r < I_WIN) { const int kt = 2 * ((r >> 1) / NT_IN) + (r & 1), nt = (r >> 1) % NT_IN; q = TrItem{a.w_in + (size_t)l * D * NIN, ws + WS_WIN + l * SZ_WIN, NIN, NIN, D, 64 * kt, 64 * nt, 0, WEB_IN}; return; } r -= I_WIN;
    if (r < I_PA) { const int kt = 2 * ((r >> 1) / 32) + (r & 1), nt = (r >> 1) % 32; q = TrItem{a.p_a + (size_t)l * 512 * D, ws + WS_PAB + l * SZ_PAB, D, D, KAB, 64 * kt, 64 * nt, 1, WEB_MRG}; return; } r -= I_PA;
    if (r < I_PB) { const int kt = 2 * ((r >> 1) / 32) + (r & 1), nt = (r >> 1) % 32; q = TrItem{a.p_b + (size_t)l * D * D, ws + WS_PAB + l * SZ_PAB + 512 * WEB_MRG, D, D, KAB, 64 * kt, 64 * nt, 1, WEB_MRG}; return; } r -= I_PB;
    if (r < I_WO) { const int kt = 2 * ((r >> 1) / 32) + (r & 1), nt = (r >> 1) % 32; q = TrItem{a.w_o + (size_t)l * D * D, ws + WS_WO + l * SZ_WO, D, D, D, 64 * kt, 64 * nt, 1, WEB_WO}; return; } r -= I_WO;
    if (r < I_WG) { const int e = r / 704, p = r % 704, kt = 2 * ((p >> 1) / 22) + (p & 1), nt = (p >> 1) % 22; q = TrItem{a.w_gate + ((size_t)l * NE + e) * D * DFF, ws + WS_WGU + l * SZ_WGU + (size_t)e * 2816 * D * WEB, DFF, DFF, D, 64 * kt, 64 * nt, 2, WEB}; return; } r -= I_WG;
    if (r < I_WG) { const int e = r / 704, p = r % 704, kt = 2 * ((p >> 1) / 22) + (p & 1), nt = (p >> 1) % 22; q = TrItem{a.w_up + ((size_t)l * NE + e) * D * DFF, ws + WS_WGU + l * SZ_WGU + (size_t)e * 2816 * D * WEB, DFF, DFF, D, 64 * kt, 64 * nt, 3, WEB}; return; } r -= I_WG;
    { const int e = r / 704, p = r % 704, kt = 2 * ((p >> 1) / 32) + (p & 1), nt = (p >> 1) % 32; q = TrItem{a.w_down + ((size_t)l * NE + e) * DFF * D, ws + WS_WD + l * SZ_WD + (size_t)e * D * ACTP * WEB, D, D, ACTP, 64 * kt, 64 * nt, 1, WEB}; }
}
__device__ __forceinline__ int tr_row(int mode, int n) {
    if (mode == 0) return n < C_GK ? n : (n < C_GA ? (NWIN - 256) + (n - C_GK) : n - 16);
    if (mode == 2) return 256 * (n >> 7) + (n & 127);
    if (mode == 3) return 256 * (n >> 7) + 128 + (n & 127);
    return n; }
__device__ __forceinline__ void tr_load(const TrItem& q, f32x4 (&v)[16], int lane) {
    const int cc = 4 * (lane & 15), kq = lane >> 4;
#pragma unroll
    for (int i = 0; i < 16; ++i) { const int kk = 4 * i + kq; v[i] = (q.n0 + cc < q.N) ? __builtin_nontemporal_load((const f32x4*)(q.src + (size_t)(q.k0 + kk) * q.ldn + q.n0 + cc)) : (f32x4){0.f, 0.f, 0.f, 0.f}; }
}
__device__ __forceinline__ void tr_store(const TrItem& q, const f32x4 (&v)[16], LAS float* scr, int lane) {
    const int cc = 4 * (lane & 15), kq = lane >> 4;
#pragma unroll
    for (int i = 0; i < 16; ++i) { const int kk = 4 * i + kq; LAS float* s = scr + kk * 65 + cc; s[0] = v[i][0]; s[1] = v[i][1]; s[2] = v[i][2]; s[3] = v[i][3]; }
    asm volatile("s_waitcnt lgkmcnt(0)" ::: "memory");
    if (q.esz == 2) { const int c = lane & 7;
#pragma unroll
        for (int j = 0; j < 8; ++j) { const int nl = (lane >> 3) + 8 * j, n = q.n0 + nl; const LAS float* s = scr + (8 * c) * 65 + nl;
            u32x4 o; o.x = cvtpk(s[0 * 65], s[1 * 65]); o.y = cvtpk(s[2 * 65], s[3 * 65]); o.z = cvtpk(s[4 * 65], s[5 * 65]); o.w = cvtpk(s[6 * 65], s[7 * 65]);
            const int row = tr_row(q.mode, n);
            if (n < q.N) *(u32x4*)(q.dst + ((size_t)row * q.ldd + q.k0 + 8 * c) * 2) = o; } }
    else { const int c = lane & 3;
#pragma unroll
        for (int j = 0; j < 4; ++j) { const int nl = (lane >> 2) + 16 * j, n = q.n0 + nl; const LAS float* s = scr + (16 * c) * 65 + nl;
            u32x4 o; o.x = cvt4_f8(s[0 * 65] * F8_WGT, s[1 * 65] * F8_WGT, s[2 * 65] * F8_WGT, s[3 * 65] * F8_WGT); o.y = cvt4_f8(s[4 * 65] * F8_WGT, s[5 * 65] * F8_WGT, s[6 * 65] * F8_WGT, s[7 * 65] * F8_WGT);
            o.z = cvt4_f8(s[8 * 65] * F8_WGT, s[9 * 65] * F8_WGT, s[10 * 65] * F8_WGT, s[11 * 65] * F8_WGT); o.w = cvt4_f8(s[12 * 65] * F8_WGT, s[13 * 65] * F8_WGT, s[14 * 65] * F8_WGT, s[15 * 65] * F8_WGT);
            const int row = tr_row(q.mode, n);
            if (n < q.N) *(u32x4*)(q.dst + (size_t)row * q.ldd + q.k0 + 16 * c) = o; } }
    asm volatile("s_waitcnt lgkmcnt(0)" ::: "memory");
}
__device__ __forceinline__ void ph_prologue(const Args& a, LAS unsigned char* lds, int gw, int NGW, int wave, int lane) {
    LAS float* scr = (LAS float*)(lds + wave * 16640);
    constexpr int NT_IN = (NIN + 63) / 64;
    constexpr int I_LAYER = 32 * NT_IN + 8 * 32 + 32 * 32 + 32 * 32 + 2 * NE * 32 * 22 + NE * 22 * 32, NITEMS = 2 * I_LAYER;
    unsigned char* ws = a.ws;
    { TrItem qa, qb; f32x4 va[16], vb[16];
        for (int m = gw; m < BGP_A; m += NGW) {
            tr_decode(a, 2 * m, qa); tr_load(qa, va, lane); tr_decode(a, 2 * m + 1, qb); tr_load(qb, vb, lane);
            tr_store(qa, va, scr, lane); tr_store(qb, vb, scr, lane); } }
    const int gt = gw * 64 + lane, NGT = NGW * 64;
    for (int i = gt; i < 2 * 240 * (D * WEB_IN / 16); i += NGT) { const int l = i / (240 * (D * WEB_IN / 16)), q = i % (240 * (D * WEB_IN / 16)); *(u32x4*)(ws + WS_WIN + l * SZ_WIN + (size_t)(NWIN - 240) * D * WEB_IN + (size_t)q * 16) = (u32x4){0u, 0u, 0u, 0u}; }
    if (F8_MOE) {
        for (int i = gt; i < 2 * NE * D * 8; i += NGT) { const int pc = i & 7, row = (i >> 3) % (NE * D), l = (i >> 3) / (NE * D); *(u32x4*)(ws + WS_WD + l * SZ_WD + (size_t)row * ACTP + DFF + pc * 16) = (u32x4){0u, 0u, 0u, 0u}; } }
    for (int i = gt; i < (int)(MiB / 16); i += NGT) *(u32x4*)(ws + P_TOK + (size_t)i * 16) = (u32x4){0u, 0u, 0u, 0u};
    float* tab = (float*)(ws + WS_TAB);
    for (int i = gt; i < T * 16; i += NGT) { const int t = i >> 4, k = i & 15; const float inv = (float)pow(500000.0, -(double)(2 * k) / 32.0); const float ang = (float)a.pos[t] * inv;
        tab[i * 2] = (float)cos((double)ang); tab[i * 2 + 1] = (float)sin((double)ang); }
    if (F8_IN) { unsigned char* hq = ws + P_HB;
        for (int i0 = gt; i0 < T * D / 16; i0 += 4 * NGT) { f32x4 p[4][4]; int ii[4];
#pragma unroll
            for (int q = 0; q < 4; ++q) { ii[q] = i0 + q * NGT < T * D / 16 ? i0 + q * NGT : i0; const f32x4* xp = (const f32x4*)(a.x + (size_t)ii[q] * 16);
                p[q][0] = __builtin_nontemporal_load(xp); p[q][1] = __builtin_nontemporal_load(xp + 1); p[q][2] = __builtin_nontemporal_load(xp + 2); p[q][3] = __builtin_nontemporal_load(xp + 3); }
#pragma unroll
            for (int q = 0; q < 4; ++q) { u32x4 o; o.x = cvt4_f8(p[q][0][0] * F8_ACT, p[q][0][1] * F8_ACT, p[q][0][2] * F8_ACT, p[q][0][3] * F8_ACT); o.y = cvt4_f8(p[q][1][0] * F8_ACT, p[q][1][1] * F8_ACT, p[q][1][2] * F8_ACT, p[q][1][3] * F8_ACT);
                o.z = cvt4_f8(p[q][2][0] * F8_ACT, p[q][2][1] * F8_ACT, p[q][2][2] * F8_ACT, p[q][2][3] * F8_ACT); o.w = cvt4_f8(p[q][3][0] * F8_ACT, p[q][3][1] * F8_ACT, p[q][3][2] * F8_ACT, p[q][3][3] * F8_ACT); *(u32x4*)(hq + (size_t)ii[q] * 16) = o; } } }
    else { u16* hb = (u16*)(ws + P_HB);
        for (int i = gt; i < T * D / 8; i += NGT) { const f32x4 p = *(const f32x4*)(a.x + (size_t)i * 8), q = *(const f32x4*)(a.x + (size_t)i * 8 + 4);
            u32x4 o; o.x = cvtpk(p[0], p[1]); o.y = cvtpk(p[2], p[3]); o.z = cvtpk(q[0], q[1]); o.w = cvtpk(q[2], q[3]); *(u32x4*)(hb + (size_t)i * 8) = o; } }
}

__device__ __forceinline__ void ph_bgconv(const Args& a, LAS unsigned char* lds, int lo, int hi, int cw, int NCW, int wave, int lane) {
    LAS float* scr = (LAS float*)(lds + wave * 16640);
    const int npw = (hi - lo - cw + NCW - 1) / NCW, nts = npw > 0 ? 2 * npw : 0;
    TrItem qa, qb, qc; f32x4 va[16], vb[16], vc[16];
    for (int sidx = 0; sidx < nts; sidx += 3) {
        tr_decode(a, 2 * (lo + cw + (sidx >> 1) * NCW) + (sidx & 1), qa); tr_load(qa, va, lane);
        if (sidx + 1 < nts) { tr_decode(a, 2 * (lo + cw + ((sidx + 1) >> 1) * NCW) + ((sidx + 1) & 1), qb); tr_load(qb, vb, lane); }
        if (sidx + 2 < nts) { tr_decode(a, 2 * (lo + cw + ((sidx + 2) >> 1) * NCW) + ((sidx + 2) & 1), qc); tr_load(qc, vc, lane); }
        tr_store(qa, va, scr, lane);
        if (sidx + 1 < nts) tr_store(qb, vb, scr, lane);
        if (sidx + 2 < nts) tr_store(qc, vc, scr, lane); }
}

__device__ __forceinline__ void ph_attn_simple(const u16* Qa, const u16* Ka, const u16* Va, u16* Oa, float* LSE, LAS unsigned char* lds, int gw, int NGW, int wave, int lane) {
    LAS float* sq = (LAS float*)(lds + wave * 2048); LAS float* sp = sq + 128;
    for (int item = gw; item < T * 12; item += NGW) {
        const int t = item / 12, head = item % 12, g = head >> 2, hh = head & 3, dil = g == 0 ? 1 : (g == 1 ? 4 : 16), b = t / SEQ, s = t % SEQ;
        const u16* q = Qa + (size_t)t * 1536 + head * 128;
        asm volatile("s_waitcnt lgkmcnt(0)" ::: "memory");
        sq[lane] = bf2f(q[lane]); sq[lane + 64] = bf2f(q[lane + 64]);
        asm volatile("s_waitcnt lgkmcnt(0)" ::: "memory");
        float sc[3]; float m = -INFINITY;
#pragma unroll
        for (int r = 0; r < 3; ++r) { const int j = lane + 64 * r; sc[r] = -INFINITY;
            if (j <= 128) { const int sk = s - j * dil;
                if (sk >= 0) { const uint4* k = (const uint4*)(Ka + (size_t)(b * SEQ + sk) * 1536 + head * 128); float a = 0.f;
                    for (int d8 = 0; d8 < 16; ++d8) { const uint4 kv = k[d8]; const unsigned ww[4] = {kv.x, kv.y, kv.z, kv.w};
#pragma unroll
                        for (int x = 0; x < 4; ++x) { a += sq[d8 * 8 + 2 * x] * bflo(ww[x]); a += sq[d8 * 8 + 2 * x + 1] * bfhi(ww[x]); } }
                    sc[r] = a; } }
            m = fmaxf(m, sc[r]); }
        m = wave_max(m);
        float den = 0.f;
#pragma unroll
        for (int r = 0; r < 3; ++r) { const int j = lane + 64 * r; const float pe = (sc[r] == -INFINITY) ? 0.f : expf(sc[r] - m); den += pe; if (j <= 128) sp[j] = pe; }
        den = wave_sum(den);
        asm volatile("s_waitcnt lgkmcnt(0)" ::: "memory");
        float o0 = 0.f, o1 = 0.f;
        for (int j = 0; j <= 128; ++j) { const int sk = s - j * dil; if (sk < 0) break; const float pj = sp[j];
            const u16* v = Va + (size_t)(b * SEQ + sk) * 1536 + head * 128; o0 += pj * bf2f(v[lane]); o1 += pj * bf2f(v[lane + 64]); }
        const float inv = 1.f / den;
        u16* o = Oa + ((size_t)g * T + t) * 512 + hh * 128; o[lane] = f2bf(o0 * inv); o[lane + 64] = f2bf(o1 * inv);
        if (lane == 0) LSE[((size_t)g * T + t) * 4 + hh] = m + logf(den);
    }
}
__device__ __forceinline__ void ya_item(float l0, float l1, float l2, u32x4 x0, u32x4 x1, u32x4 x2, int idx, u16* __restrict__ ya) {
    const int t = idx >> 6, c = (idx & 63) * 8;
    const float mx = fmaxf(l0, fmaxf(l1, l2)); float e0 = __expf(l0 - mx), e1 = __expf(l1 - mx), e2 = __expf(l2 - mx); const float inv = 1.f / (e0 + e1 + e2); e0 *= inv; e1 *= inv; e2 *= inv;
    const float o0 = e0 * bflo(x0.x) + e1 * bflo(x1.x) + e2 * bflo(x2.x), o1 = e0 * bfhi(x0.x) + e1 * bfhi(x1.x) + e2 * bfhi(x2.x), o2 = e0 * bflo(x0.y) + e1 * bflo(x1.y) + e2 * bflo(x2.y), o3 = e0 * bfhi(x0.y) + e1 * bfhi(x1.y) + e2 * bfhi(x2.y);
    const float o4 = e0 * bflo(x0.z) + e1 * bflo(x1.z) + e2 * bflo(x2.z), o5 = e0 * bfhi(x0.z) + e1 * bfhi(x1.z) + e2 * bfhi(x2.z), o6 = e0 * bflo(x0.w) + e1 * bflo(x1.w) + e2 * bflo(x2.w), o7 = e0 * bfhi(x0.w) + e1 * bfhi(x1.w) + e2 * bfhi(x2.w);
    if (F8_MRG) { u32x2 w8; w8.x = cvt4_f8(o0 * F8_ACT, o1 * F8_ACT, o2 * F8_ACT, o3 * F8_ACT); w8.y = cvt4_f8(o4 * F8_ACT, o5 * F8_ACT, o6 * F8_ACT, o7 * F8_ACT); *(u32x2*)((unsigned char*)ya + (size_t)t * KAB + c) = w8; }
    else { u32x4 w; w.x = cvtpk(o0, o1); w.y = cvtpk(o2, o3); w.z = cvtpk(o4, o5); w.w = cvtpk(o6, o7); *(u32x4*)(ya + (size_t)t * KAB + c) = w; }
}
struct YaPre { float l[4][3]; u32x4 x[4][3]; };
__device__ __forceinline__ void ya_request(const u16* __restrict__ Oa, const float* __restrict__ LSE, int gt, int NGT, YaPre& p) {
#pragma unroll
    for (int q = 0; q < 4; ++q) { const int idx = gt + q * NGT < T * 64 ? gt + q * NGT : gt, t = idx >> 6, c = (idx & 63) * 8, hh = c >> 7;
#pragma unroll
        for (int g = 0; g < 3; ++g) { p.l[q][g] = LSE[((size_t)g * T + t) * 4 + hh]; p.x[q][g] = *(const u32x4*)(Oa + ((size_t)g * T + t) * 512 + c); } }
    asm volatile("" ::: "memory");
}
__device__ __forceinline__ void ya_finish(const YaPre& p, u16* __restrict__ ya, int gt, int NGT) {
#pragma unroll
    for (int q = 0; q < 4; ++q) { const int idx = gt + q * NGT < T * 64 ? gt + q * NGT : gt; ya_item(p.l[q][0], p.l[q][1], p.l[q][2], p.x[q][0], p.x[q][1], p.x[q][2], idx, ya); }
}
__device__ __forceinline__ void ph_ya(const u16* __restrict__ Oa, const float* __restrict__ LSE, u16* __restrict__ ya, int gt, int NGT) {
    for (int idx0 = gt; idx0 < T * 64; idx0 += 2 * NGT) { const bool h2 = idx0 + NGT < T * 64; const int id[2] = {idx0, h2 ? idx0 + NGT : idx0};
        float l0[2], l1[2], l2[2]; u32x4 a0[2], a1[2], a2[2];
#pragma unroll
        for (int q = 0; q < 2; ++q) { const int t = id[q] >> 6, c = (id[q] & 63) * 8, hh = c >> 7;
            l0[q] = LSE[((size_t)0 * T + t) * 4 + hh]; l1[q] = LSE[((size_t)1 * T + t) * 4 + hh]; l2[q] = LSE[((size_t)2 * T + t) * 4 + hh];
            a0[q] = *(const u32x4*)(Oa + ((size_t)0 * T + t) * 512 + c); a1[q] = *(const u32x4*)(Oa + ((size_t)1 * T + t) * 512 + c); a2[q] = *(const u32x4*)(Oa + ((size_t)2 * T + t) * 512 + c); }
#pragma unroll
        for (int q = 0; q < 2; ++q) { const int t = id[q] >> 6, c = (id[q] & 63) * 8;
            const float mx = fmaxf(l0[q], fmaxf(l1[q], l2[q])); float e0 = __expf(l0[q] - mx), e1 = __expf(l1[q] - mx), e2 = __expf(l2[q] - mx); const float inv = 1.f / (e0 + e1 + e2); e0 *= inv; e1 *= inv; e2 *= inv;
            const u32x4 x0 = a0[q], x1 = a1[q], x2 = a2[q];
            const float o0 = e0 * bflo(x0.x) + e1 * bflo(x1.x) + e2 * bflo(x2.x), o1 = e0 * bfhi(x0.x) + e1 * bfhi(x1.x) + e2 * bfhi(x2.x), o2 = e0 * bflo(x0.y) + e1 * bflo(x1.y) + e2 * bflo(x2.y), o3 = e0 * bfhi(x0.y) + e1 * bfhi(x1.y) + e2 * bfhi(x2.y);
            const float o4 = e0 * bflo(x0.z) + e1 * bflo(x1.z) + e2 * bflo(x2.z), o5 = e0 * bfhi(x0.z) + e1 * bfhi(x1.z) + e2 * bfhi(x2.z), o6 = e0 * bflo(x0.w) + e1 * bflo(x1.w) + e2 * bflo(x2.w), o7 = e0 * bfhi(x0.w) + e1 * bfhi(x1.w) + e2 * bfhi(x2.w);
            if (F8_MRG) { u32x2 w8; w8.x = cvt4_f8(o0 * F8_ACT, o1 * F8_ACT, o2 * F8_ACT, o3 * F8_ACT); w8.y = cvt4_f8(o4 * F8_ACT, o5 * F8_ACT, o6 * F8_ACT, o7 * F8_ACT); *(u32x2*)((unsigned char*)ya + (size_t)t * KAB + c) = w8; }
            else { u32x4 w; w.x = cvtpk(o0, o1); w.y = cvtpk(o2, o3); w.z = cvtpk(o4, o5); w.w = cvtpk(o6, o7); *(u32x4*)(ya + (size_t)t * KAB + c) = w; } } }
}
typedef short v4i16_t __attribute__((ext_vector_type(4)));
__device__ __forceinline__ void ph_attn(const u16* __restrict__ Qa, const u16* __restrict__ Ka, const u16* __restrict__ Va, u16* __restrict__ Oa, float* __restrict__ LSE, LAS unsigned char* lds, int bx, int G, int wv) {
    int tid = WV_TID(wv); asm volatile("" : "+v"(tid));
    const int wid = __builtin_amdgcn_readfirstlane(tid >> 6), lane = tid & 63, i16 = lane & 15, g4 = lane >> 4;
    constexpr int RS = 272, VOFF = 256 * RS;
    const int kt0 = wid < 6 ? wid : 6;
    const int pc = tid & 15, row0 = tid >> 4;
    u32x4 kreg[8], vreg[8]; bf16x8 qn[4];
#define AT_DECODE(u0_) const int u = pg8::xcd_remap((u0_), 768);   \
        const int bh = u >> 5, sub = u & 31, b = bh / 12, head = bh - 12 * b, grp = head >> 2, hh = head & 3; \
        const int dsh = 2 * grp, dil = 1 << dsh, nb = 32 >> dsh, r = sub / nb, bq = sub - r * nb;       \
        const int qq = 16 * wid + i16; const size_t tq = (size_t)b * SEQ + (size_t)(128 * bq + qq) * dil + r
#define AT_REQUEST() do { _Pragma("unroll") for (int j = 0; j < 8; ++j) { const int c = row0 + 32 * j, l = 128 * (bq - 1) + c; \
            if (l >= 0) { const size_t off = ((size_t)b * SEQ + (size_t)l * dil + r) * 1536 + head * 128 + pc * 8; kreg[j] = *(const u32x4*)(Ka + off); vreg[j] = *(const u32x4*)(Va + off); } \
            else { kreg[j] = (u32x4){0u, 0u, 0u, 0u}; vreg[j] = (u32x4){0u, 0u, 0u, 0u}; } } \
        _Pragma("unroll") for (int ks = 0; ks < 4; ++ks) qn[ks] = *(const bf16x8*)(Qa + tq * 1536 + head * 128 + 32 * ks + 8 * g4); } while (0)
    if (bx < 768) { AT_DECODE(bx); AT_REQUEST(); (void)grp; (void)hh; (void)qq; }
    for (int u0 = bx; u0 < 768; u0 += G) {
        AT_DECODE(u0);
        bf16x8 qf[4];
#pragma unroll
        for (int ks = 0; ks < 4; ++ks) qf[ks] = qn[ks];
#pragma unroll
        for (int j = 0; j < 8; ++j) { const int c = row0 + 32 * j; *(LAS u32x4*)(lds + c * RS + pc * 16) = kreg[j]; *(LAS u32x4*)(lds + VOFF + c * RS + pc * 16) = vreg[j]; }
        __syncthreads();
        if (u0 + G < 768) { int un = u0 + G; asm volatile("" : "+s"(un)); { AT_DECODE(un); AT_REQUEST(); (void)grp; (void)hh; (void)qq; } asm volatile("" ::: "memory"); }
        f32x4 sc[10];
#pragma unroll
        for (int kk = 0; kk < 10; ++kk) { sc[kk] = (f32x4){0.f, 0.f, 0.f, 0.f};
#pragma unroll
            for (int ks = 0; ks < 4; ++ks) { const bf16x8 kf = *(const LAS bf16x8*)(lds + (16 * (kt0 + kk) + i16) * RS + (32 * ks + 8 * g4) * 2);
                sc[kk] = __builtin_amdgcn_mfma_f32_16x16x32_bf16(kf, qf[ks], sc[kk], 0, 0, 0); } }
        float m = -INFINITY;
#pragma unroll
        for (int kk = 0; kk < 10; ++kk)
#pragma unroll
            for (int rr = 0; rr < 4; ++rr) { const int c = 16 * (kt0 + kk) + 4 * g4 + rr; const bool ok = (c >= qq) && (c <= qq + 128) && (bq > 0 || c >= 128);
                sc[kk][rr] = ok ? sc[kk][rr] : -INFINITY; m = fmaxf(m, sc[kk][rr]); }
        m = fmaxf(m, __shfl_xor(m, 16)); m = fmaxf(m, __shfl_xor(m, 32));
        float den = 0.f;
#pragma unroll
        for (int kk = 0; kk < 10; ++kk)
#pragma unroll
            for (int rr = 0; rr < 4; ++rr) { const float p = exp2f((sc[kk][rr] - m) * 1.4426950408889634f); sc[kk][rr] = p; den += p; }
        den += __shfl_xor(den, 16); den += __shfl_xor(den, 32);
        f32x4 o[8];
#pragma unroll
        for (int dt = 0; dt < 8; ++dt) o[dt] = (f32x4){0.f, 0.f, 0.f, 0.f};
        const int q4 = i16 >> 2, p4 = i16 & 3;
#pragma unroll
        for (int pr = 0; pr < 5; ++pr) {
            u32x4 pw; pw.x = cvtpk(sc[2 * pr][0], sc[2 * pr][1]); pw.y = cvtpk(sc[2 * pr][2], sc[2 * pr][3]); pw.z = cvtpk(sc[2 * pr + 1][0], sc[2 * pr + 1][1]); pw.w = cvtpk(sc[2 * pr + 1][2], sc[2 * pr + 1][3]);
            const bf16x8 pf = __builtin_bit_cast(bf16x8, pw);
            const int rlo = 16 * (kt0 + 2 * pr) + 4 * g4 + q4, rhi = rlo + 16;
#pragma unroll
            for (int dt = 0; dt < 8; ++dt) {
                const v4i16_t lo = __builtin_amdgcn_ds_read_tr16_b64_v4i16((LAS v4i16_t*)(lds + VOFF + rlo * RS + (16 * dt + 4 * p4) * 2));
                const v4i16_t hi = __builtin_amdgcn_ds_read_tr16_b64_v4i16((LAS v4i16_t*)(lds + VOFF + rhi * RS + (16 * dt + 4 * p4) * 2));
                const bf16x8 vf = (bf16x8){lo[0], lo[1], lo[2], lo[3], hi[0], hi[1], hi[2], hi[3]};
                o[dt] = __builtin_amdgcn_mfma_f32_16x16x32_bf16(vf, pf, o[dt], 0, 0, 0); } }
        const float inv = 1.f / den;
        u16* op = Oa + ((size_t)grp * T + tq) * 512 + hh * 128 + 4 * g4;
#pragma unroll
        for (int dt = 0; dt < 8; ++dt) { u32x2 w; w.x = cvtpk(o[dt][0] * inv, o[dt][1] * inv); w.y = cvtpk(o[dt][2] * inv, o[dt][3] * inv); *(u32x2*)(op + 16 * dt) = w; }
        if (g4 == 0) LSE[((size_t)grp * T + tq) * 4 + hh] = m + logf(den);
        __syncthreads();
    }
#undef AT_DECODE
#undef AT_REQUEST
}
constexpr int GP_QL = 0, GP_KL = 33792, GP_GK = 67584, GP_TOT = 71680, GP_VL = 73728, GP_ROW = 528, GP_VROW = 1040;
__device__ __forceinline__ void ph_gla_prep(const u16* __restrict__ Qb, const u16* __restrict__ Kb, const u16* __restrict__ Vb, const float* __restrict__ gkl, const float* __restrict__ wgk2, const float* __restrict__ bgk,
                                            u16* __restrict__ QT, u16* __restrict__ KDT, u16* __restrict__ VT, u16* __restrict__ ATT, float* __restrict__ DEC, LAS unsigned char* lds, int bx, int G, int wv) {
    int tid = WV_TID(wv); asm volatile("" : "+v"(tid));
    const int wid = __builtin_amdgcn_readfirstlane(tid >> 6), lane = tid & 63, i16 = lane & 15, g4 = lane >> 4, ch = tid & 255, half = tid >> 8;
    f32x4 gkr = (f32x4){0.f, 0.f, 0.f, 0.f}; u32x4 vr[8], qr[4], kr[4]; float wkn[16], bkn = 0.f;
#define GP_REQUEST(u_) do { const int n_ = (u_) & 63, bh_ = (u_) >> 6, h_ = bh_ & 3, b_ = bh_ >> 2; const size_t t0_ = (size_t)b_ * SEQ + 64 * n_; \
        if (tid < 256) gkr = *(const f32x4*)(gkl + t0_ * 16 + tid * 4); \
        _Pragma("unroll") for (int j = 0; j < 8; ++j) { const int row = (tid >> 6) + 8 * j, pc = tid & 63; vr[j] = *(const u32x4*)(Vb + (t0_ + row) * 2048 + h_ * 512 + pc * 8); } \
        _Pragma("unroll") for (int j = 0; j < 4; ++j) { const int row = (tid >> 5) + 16 * j, pc = tid & 31; const size_t go = (t0_ + row) * 1024 + h_ * 256 + pc * 8; qr[j] = *(const u32x4*)(Qb + go); kr[j] = *(const u32x4*)(Kb + go); } \
        _Pragma("unroll") for (int j = 0; j < 16; ++j) wkn[j] = wgk2[j * 1024 + h_ * 256 + ch]; \
        bkn = bgk[h_ * 256 + ch]; } while (0)
    if (bx < 512) GP_REQUEST(bx);
    for (int u = bx; u < 512; u += G) {
        const int n = u & 63, bh = u >> 6, h = bh & 3, b = bh >> 2; const size_t t0 = (size_t)b * SEQ + 64 * n;
        if (tid < 256) *(LAS f32x4*)(lds + GP_GK + tid * 16) = gkr;
#pragma unroll
        for (int j = 0; j < 8; ++j) { const int row = (tid >> 6) + 8 * j, pc = tid & 63; *(LAS u32x4*)(lds + GP_VL + row * GP_VROW + ((pc + (row >> 3)) & 63) * 16) = vr[j]; }
#pragma unroll
        for (int j = 0; j < 4; ++j) { const int row = (tid >> 5) + 16 * j, pc = tid & 31;
            *(LAS u32x4*)(lds + GP_QL + row * GP_ROW + pc * 16) = qr[j]; *(LAS u32x4*)(lds + GP_KL + row * GP_ROW + pc * 16) = kr[j]; }
        float wk[16];
#pragma unroll
        for (int j = 0; j < 16; ++j) wk[j] = wkn[j];
        const float bk = bkn;
        __syncthreads();
        if (u + G < 512) { int un = u + G; asm volatile("" : "+s"(un)); GP_REQUEST(un); asm volatile("" ::: "memory"); }
        float bl[32]; float run = 0.f;
#pragma unroll
        for (int i = 0; i < 32; i += 2) { const LAS f32x4* gp = (const LAS f32x4*)(lds + GP_GK + (half * 32 + i) * 64); f32x2v gk2 = (f32x2v){bk, bk};
#pragma unroll
            for (int j4 = 0; j4 < 4; ++j4) { const f32x4 ga = gp[j4], gb = gp[4 + j4];
#pragma unroll
                for (int k = 0; k < 4; ++k) gk2 += (f32x2v){ga[k], gb[k]} * wk[4 * j4 + k]; }
#pragma unroll
            for (int q = 0; q < 2; ++q) { const float gk = gk2[q]; const float ls = fminf(gk, 0.f) - __logf(1.f + __expf(-fabsf(gk))); run += ls * (1.f / 16.f); bl[i + q] = run; } }
        *(LAS float*)(lds + GP_TOT + (half * 256 + ch) * 4) = run;
#pragma unroll
        for (int j = 0; j < 8; ++j) { const int p = tid + 512 * j, v = p >> 3, c8 = p & 7; unsigned w[4];
#pragma unroll
            for (int q = 0; q < 4; ++q) { const int vo = (((v >> 3) + c8) & 63) * 16 + (v & 7) * 2; const unsigned lo = *(const LAS u16*)(lds + GP_VL + (8 * c8 + 2 * q) * GP_VROW + vo), hi = *(const LAS u16*)(lds + GP_VL + (8 * c8 + 2 * q + 1) * GP_VROW + vo); w[q] = lo | (hi << 16); }
            *(u32x4*)(VT + ((size_t)u * 512 + v) * 64 + 8 * c8) = (u32x4){w[0], w[1], w[2], w[3]}; }
        __syncthreads();
        const float tot0 = *(const LAS float*)(lds + GP_TOT + ch * 4), tot1 = *(const LAS float*)(lds + GP_TOT + (256 + ch) * 4); const float blast = tot0 + tot1, boff = half ? tot0 : 0.f;
        unsigned kd[16]; float kdprev = 0.f;
#pragma unroll
        for (int i = 0; i < 32; ++i) { const int c = half * 32 + i; const float bb = bl[i] + boff;
            LAS u16* qlp = (LAS u16*)(lds + GP_QL + c * GP_ROW + ch * 2); LAS u16* klp = (LAS u16*)(lds + GP_KL + c * GP_ROW + ch * 2);
            const float q = bf2f(*qlp), k = bf2f(*klp);
            const float eb = __expf(bb), qt = q * 0.0625f * eb, kt = k * __builtin_amdgcn_rcpf(eb), kdv = k * __expf(blast - bb);
            { const unsigned qk = cvtpk(qt, kt); *qlp = (u16)qk; *klp = (u16)(qk >> 16); }
            if (i & 1) kd[i >> 1] = cvtpk(kdprev, kdv); else kdprev = kdv; }
        { u16* kp = KDT + ((size_t)u * 256 + ch) * 64 + half * 32;
#pragma unroll
            for (int q = 0; q < 4; ++q) *(u32x4*)(kp + 8 * q) = (u32x4){kd[4 * q], kd[4 * q + 1], kd[4 * q + 2], kd[4 * q + 3]}; }
        if (half == 0) DEC[(size_t)u * 256 + ch] = __expf(blast);
        __syncthreads();
#pragma unroll
        for (int j = 0; j < 4; ++j) { const int row = (tid >> 5) + 16 * j, pc = tid & 31; *(u32x4*)(QT + (t0 + row) * 1024 + h * 256 + pc * 8) = *(const LAS u32x4*)(lds + GP_QL + row * GP_ROW + pc * 16); }
#pragma unroll
        for (int tt = 0; tt < 2; ++tt) { const int id = 2 * wid + tt, st = id >> 2, ct = id & 3; f32x4 acc = (f32x4){0.f, 0.f, 0.f, 0.f};
            if (st <= ct) {
#pragma unroll
                for (int kk = 0; kk < 8; ++kk) { const bf16x8 af = *(const LAS bf16x8*)(lds + GP_KL + (16 * st + i16) * GP_ROW + (32 * kk + 8 * g4) * 2), bf = *(const LAS bf16x8*)(lds + GP_QL + (16 * ct + i16) * GP_ROW + (32 * kk + 8 * g4) * 2);
                    acc = __builtin_amdgcn_mfma_f32_16x16x32_bf16(af, bf, acc, 0, 0, 0); } }
            const int c = 16 * ct + i16, s0 = 16 * st + 4 * g4;
#pragma unroll
            for (int r = 0; r < 4; ++r) acc[r] = (s0 + r <= c) ? acc[r] : 0.f;
            u32x2 w; w.x = cvtpk(acc[0], acc[1]); w.y = cvtpk(acc[2], acc[3]); *(u32x2*)(ATT + (size_t)u * 4096 + c * 64 + s0) = w; }
        __syncthreads();
    }
#undef GP_REQUEST
}
constexpr int GS_SLOT = 16640, GS_B = 8192, GS_D = 16384;
template <int N> __device__ __forceinline__ void gs_wait() { asm volatile("s_waitcnt vmcnt(%0)" :: "n"(N) : "memory"); }
__device__ __forceinline__ void gs_wait_n(int n) { switch (n) { case 0: gs_wait<18>(); break; case 1: gs_wait<19>(); break; case 2: gs_wait<20>(); break; case 3: gs_wait<21>(); break; case 4: gs_wait<22>(); break; case 5: gs_wait<23>(); break; default: gs_wait<24>(); break; } }
template <bool DOSTORE = true>
__device__ __forceinline__ void ph_gla_scan(const u16* __restrict__ KDT, const u16* __restrict__ VT, const float* __restrict__ DEC, u16* __restrict__ SN, LAS unsigned char* lds, int bx, int G, int wv) {
    int tid = WV_TID(wv); asm volatile("" : "+v"(tid));
    const int wid = __builtin_amdgcn_readfirstlane(tid >> 6), lane = tid & 63, i16 = lane & 15, g4 = lane >> 4;
    for (int it0 = bx; it0 < 256; it0 += G) {
        const int it = (G & 7) == 0 ? ((it0 & 7) << 5) | ((it0 >> 3) & 31) : it0;
        const int vb = it & 7, kb = (it >> 3) & 3, bh = it >> 5;
        const int kp = wid >> 2, kc = kb * 2 + kp, v0 = vb * 64 + 16 * (wid & 3);
        const int lr = 8 * wid + (lane >> 3), lp = lane & 7;
        const int fa = ((lr >> 1) & 1) | (((lr >> 3) & 3) << 1), fb = (lr >> 1) & 7;
        const unsigned ga_off = (unsigned)((kb * 64 + lr) * 128 + ((lp ^ fa) << 4)), gb_off = (unsigned)((vb * 64 + lr) * 128 + ((lp ^ fb) << 4));
        const char* kdt_b = (const char*)KDT + (size_t)bh * 64 * 256 * 128; const char* vt_b = (const char*)VT + (size_t)bh * 64 * 512 * 128; const char* dec_b = (const char*)DEC + (size_t)bh * 64 * 1024 + kb * 256 + lane * 4;
#define GS_ISSUE(n_) do { const int nn_ = (n_) < 64 ? (n_) : 63; LAS unsigned char* sl_ = lds + ((n_) & 7) * GS_SLOT; \
        __builtin_amdgcn_global_load_lds((const unsigned*)(kdt_b + (size_t)nn_ * 256 * 128 + ga_off), (LAS unsigned*)(sl_ + wid * 1024), 16, 0, 0); \
        __builtin_amdgcn_global_load_lds((const unsigned*)(vt_b + (size_t)nn_ * 512 * 128 + gb_off), (LAS unsigned*)(sl_ + GS_B + wid * 1024), 16, 0, 0); \
        __builtin_amdgcn_global_load_lds((const unsigned*)(dec_b + (size_t)nn_ * 1024), (LAS unsigned*)(sl_ + GS_D), 4, 0, 0); } while (0)
        const int ar0 = 32 * kp + 8 * (i16 >> 2) + (i16 & 3), ar1 = ar0 + 4, br = 16 * (wid & 3) + i16;
        const int fa0 = ((ar0 >> 1) & 1) | (((ar0 >> 3) & 3) << 1), fa1 = ((ar1 >> 1) & 1) | (((ar1 >> 3) & 3) << 1), fbr = (br >> 1) & 7;
        const int oa00 = ar0 * 128 + ((g4 ^ fa0) << 4), oa01 = ar0 * 128 + (((4 + g4) ^ fa0) << 4), oa10 = ar1 * 128 + ((g4 ^ fa1) << 4), oa11 = ar1 * 128 + (((4 + g4) ^ fa1) << 4);
        const int ob0 = GS_B + br * 128 + ((g4 ^ fbr) << 4), ob1 = GS_B + br * 128 + (((4 + g4) ^ fbr) << 4), od = GS_D + (32 * kp + 8 * g4) * 4;
        f32x4 S0 = (f32x4){0.f, 0.f, 0.f, 0.f}, S1 = S0;
        GS_ISSUE(0); GS_ISSUE(1); GS_ISSUE(2); GS_ISSUE(3); GS_ISSUE(4); GS_ISSUE(5); GS_ISSUE(6);
#define GS_STEP(n_) do { \
        if (__builtin_constant_p(n_) && (n_) < 7) gs_wait_n((n_)); else gs_wait<25>();                            \
        __builtin_amdgcn_s_barrier();                                      \
        GS_ISSUE((n_) + 7);                                                \
        const LAS unsigned char* sl = lds + ((n_) & 7) * GS_SLOT; \
        const bf16x8 a00 = *(const LAS bf16x8*)(sl + oa00), a01 = *(const LAS bf16x8*)(sl + oa01), a10 = *(const LAS bf16x8*)(sl + oa10), a11 = *(const LAS bf16x8*)(sl + oa11); \
        const bf16x8 b0 = *(const LAS bf16x8*)(sl + ob0), b1 = *(const LAS bf16x8*)(sl + ob1); const f32x4 d0 = *(const LAS f32x4*)(sl + od), d1 = *(const LAS f32x4*)(sl + od + 16); \
        const size_t u = (size_t)bh * 64 + (n_); \
        u32x4 w; w.x = cvtpk(S0[0], S0[1]); w.y = cvtpk(S0[2], S0[3]); w.z = cvtpk(S1[0], S1[1]); w.w = cvtpk(S1[2], S1[3]); \
        if (!DOSTORE) asm volatile("" :: "v"(w)); \
        else if (SN_F8) { u32x2 w8; w8.x = cvt4_f8(S0[0], S0[1], S0[2], S0[3]); w8.y = cvt4_f8(S1[0], S1[1], S1[2], S1[3]); *(u32x2*)((unsigned char*)SN + ((u * 8 + kc) * 512 + v0 + i16) * 32 + 8 * g4) = w8; } \
        else *(u32x4*)(SN + ((u * 8 + kc) * 512 + v0 + i16) * 32 + 8 * g4) = w; \
        S0 = S0 * d0; S1 = S1 * d1; \
        S0 = __builtin_amdgcn_mfma_f32_16x16x32_bf16(a00, b0, S0, 0, 0, 0); S0 = __builtin_amdgcn_mfma_f32_16x16x32_bf16(a01, b1, S0, 0, 0, 0); \
        S1 = __builtin_amdgcn_mfma_f32_16x16x32_bf16(a10, b0, S1, 0, 0, 0); S1 = __builtin_amdgcn_mfma_f32_16x16x32_bf16(a11, b1, S1, 0, 0, 0); } while (0)
#define GS_STEP8(n_) GS_STEP(n_); GS_STEP((n_) + 1); GS_STEP((n_) + 2); GS_STEP((n_) + 3); GS_STEP((n_) + 4); GS_STEP((n_) + 5); GS_STEP((n_) + 6); GS_STEP((n_) + 7)
        GS_STEP8(0);
        for (int nb = 8; nb < 64; nb += 8) { GS_STEP8(nb); }
#undef GS_STEP8
#undef GS_STEP
#undef GS_ISSUE
        asm volatile("s_waitcnt vmcnt(0)" ::: "memory"); __syncthreads();
    }
}
template <int MODE = 0>
__device__ __forceinline__ void ph_gla_out(const u16* __restrict__ SN, const u16* __restrict__ QT, const u16* __restrict__ VT, const u16* __restrict__ ATT, const float* __restrict__ gg, const u16* __restrict__ Rb, u16* __restrict__ yab, LAS unsigned char* lds, int bx, int G, int wv) {
    int tid = WV_TID(wv); asm volatile("" : "+v"(tid));
    const int wid = __builtin_amdgcn_readfirstlane(tid >> 6), lane = tid & 63, i16 = lane & 15, g4 = lane >> 4;
    LAS float* part = (LAS float*)lds;
    u32x2 pa[1][4]; bf16x8 pq[1][4];
#define GO_PRE(u_) do { const int n_ = (u_) & 63, bh_ = (u_) >> 6, h_ = bh_ & 3, b_ = bh_ >> 2; const size_t t0_ = (size_t)b_ * SEQ + 64 * n_; \
        _Pragma("unroll") for (int s_ = 0; s_ < 1; ++s_) _Pragma("unroll") for (int x = 0; x < 4; ++x) { \
            pa[s_][x] = *(const u32x2*)((const unsigned char*)SN + (((size_t)(u_) * 8 + s_) * 512 + 64 * wid + x * 16 + i16) * 32 + 8 * g4); \
            pq[s_][x] = *(const bf16x8*)(QT + (t0_ + i16 + (size_t)x * 16) * 1024 + h_ * 256 + 8 * g4 + 32 * s_); } } while (0)
    if (SN_F8 && MODE == 0 && bx < 512) { GO_PRE(bx); asm volatile("" ::: "memory"); }
    for (int u = bx; u < 512; u += G) {
        const int n = u & 63, bh = u >> 6, h = bh & 3, b = bh >> 2; const size_t t0 = (size_t)b * SEQ + 64 * n;
        f32x4 acc[4][4];
#pragma unroll
        for (int vt = 0; vt < 4; ++vt)
#pragma unroll
            for (int ct = 0; ct < 4; ++ct) acc[vt][ct] = (f32x4){0.f, 0.f, 0.f, 0.f};
        const u16* sp = SN + ((size_t)u * 8 * 512 + 64 * wid + i16) * 32 + 8 * g4; const u16* qp = QT + (t0 + i16) * 1024 + h * 256 + 8 * g4;
        const u16* vp = VT + ((size_t)u * 512 + 64 * wid + i16) * 64 + 8 * g4; const u16* ap = ATT + (size_t)u * 4096 + i16 * 64 + 8 * g4;
        bf16x8 af[2][4], bf[2][4];
#define GO_LOAD(buf_, j_) do { if ((j_) < 8) { _Pragma("unroll") for (int x = 0; x < 4; ++x) { af[buf_][x] = SN_F8 ? ld_f8x8((const unsigned char*)SN + (((size_t)u * 8 + (j_)) * 512 + 64 * wid + x * 16 + i16) * 32 + 8 * g4) : *(const bf16x8*)(sp + ((size_t)(j_) * 512 + x * 16) * 32); bf[buf_][x] = *(const bf16x8*)(qp + (size_t)x * 16 * 1024 + 32 * (j_)); } } \
        else { _Pragma("unroll") for (int x = 0; x < 4; ++x) { af[buf_][x] = *(const bf16x8*)(vp + (size_t)x * 16 * 64 + 32 * ((j_) - 8)); bf[buf_][x] = *(const bf16x8*)(ap + (size_t)x * 16 * 64 + 32 * ((j_) - 8)); } } } while (0)
#define GO_MMA(buf_) do { _Pragma("unroll") for (int vt = 0; vt < 4; ++vt) _Pragma("unroll") for (int ct = 0; ct < 4; ++ct) acc[vt][ct] = __builtin_amdgcn_mfma_f32_16x16x32_bf16(af[buf_][vt], bf[buf_][ct], acc[vt][ct], 0, 0, 0); } while (0)
        if (MODE != 2) {
        if (SN_F8 && MODE == 0) {
#pragma unroll
            for (int s_ = 0; s_ < 1; ++s_)
#pragma unroll
                for (int x = 0; x < 4; ++x) { const f32x2v a_ = __builtin_amdgcn_cvt_pk_f32_fp8((int)pa[s_][x].x, false), b_ = __builtin_amdgcn_cvt_pk_f32_fp8((int)pa[s_][x].x, true), c_ = __builtin_amdgcn_cvt_pk_f32_fp8((int)pa[s_][x].y, false), d_ = __builtin_amdgcn_cvt_pk_f32_fp8((int)pa[s_][x].y, true);
                    u32x4 w_; w_.x = cvtpk(a_[0], a_[1]); w_.y = cvtpk(b_[0], b_[1]); w_.z = cvtpk(c_[0], c_[1]); w_.w = cvtpk(d_[0], d_[1]); af[s_][x] = __builtin_bit_cast(bf16x8, w_); bf[s_][x] = pq[s_][x]; }
            GO_LOAD(1, 1); }
        else { GO_LOAD(0, 0); GO_LOAD(1, 1); }
        GO_MMA(0); GO_LOAD(0, 2); GO_MMA(1); GO_LOAD(1, 3); GO_MMA(0); GO_LOAD(0, 4); GO_MMA(1); GO_LOAD(1, 5);
        GO_MMA(0); GO_LOAD(0, 6); GO_MMA(1); GO_LOAD(1, 7); GO_MMA(0); GO_LOAD(0, 8); GO_MMA(1); GO_LOAD(1, 9); GO_MMA(0); GO_MMA(1);
        }
#undef GO_LOAD
#undef GO_MMA
        if (MODE == 1) { _Pragma("unroll") for (int vt = 0; vt < 4; ++vt) _Pragma("unroll") for (int ct = 0; ct < 4; ++ct) asm volatile("" :: "v"(acc[vt][ct])); continue; }
        u32x4 rbv[8];
#pragma unroll
        for (int j = 0; j < 8; ++j) { const int p = tid + 512 * j, c = p >> 6, v8 = (p & 63) * 8; rbv[j] = *(const u32x4*)(Rb + (t0 + c) * 2048 + h * 512 + v8); }
        if (SN_F8 && MODE == 0 && u + G < 512) { int un = u + G; asm volatile("" : "+s"(un)); GO_PRE(un); }
        asm volatile("" ::: "memory"); __builtin_amdgcn_sched_barrier(0);
#pragma unroll
        for (int ct = 0; ct < 4; ++ct) { float ss = 0.f;
#pragma unroll
            for (int vt = 0; vt < 4; ++vt) ss += (acc[vt][ct][0] * acc[vt][ct][0] + acc[vt][ct][1] * acc[vt][ct][1]) + (acc[vt][ct][2] * acc[vt][ct][2] + acc[vt][ct][3] * acc[vt][ct][3]);
            ss += __shfl_xor(ss, 16); ss += __shfl_xor(ss, 32);
            if (g4 == 0) part[wid * 64 + 16 * ct + i16] = ss; }
        __syncthreads();
        constexpr int OT = 4096, OROW = 1040;
#pragma unroll
        for (int ct = 0; ct < 4; ++ct) { float tot = 0.f;
#pragma unroll
            for (int w = 0; w < 8; ++w) tot += part[w * 64 + 16 * ct + i16];
            const float rstd = rsqrtf(tot * (1.f / 512.f) + 1e-6f);
#pragma unroll
            for (int vt = 0; vt < 4; ++vt) { const int v = 64 * wid + 16 * vt + 4 * g4; const f32x4 gv = *(const f32x4*)(gg + v); const f32x4 o = acc[vt][ct] * rstd * gv;
                u32x2 w; w.x = cvtpk(o[0], o[1]); w.y = cvtpk(o[2], o[3]); *(LAS u32x2*)(lds + OT + (16 * ct + i16) * OROW + v * 2) = w; } }
        __syncthreads();
#pragma unroll
        for (int j = 0; j < 8; ++j) { const int p = tid + 512 * j, c = p >> 6, v8 = (p & 63) * 8; const size_t t = t0 + c;
            const u32x4 ov = *(const LAS u32x4*)(lds + OT + c * OROW + v8 * 2), rb = rbv[j];
            if (F8_MRG) { u32x2 w8; w8.x = cvt4_f8(bflo(ov.x) * bflo(rb.x) * F8_ACT, bfhi(ov.x) * bfhi(rb.x) * F8_ACT, bflo(ov.y) * bflo(rb.y) * F8_ACT, bfhi(ov.y) * bfhi(rb.y) * F8_ACT);
                w8.y = cvt4_f8(bflo(ov.z) * bflo(rb.z) * F8_ACT, bfhi(ov.z) * bfhi(rb.z) * F8_ACT, bflo(ov.w) * bflo(rb.w) * F8_ACT, bfhi(ov.w) * bfhi(rb.w) * F8_ACT);
                if (MODE != 2) *(u32x2*)((unsigned char*)yab + t * KAB + 512 + h * 512 + v8) = w8; else asm volatile("" :: "v"(w8)); }
            else { u32x4 w; w.x = cvtpk(bflo(ov.x) * bflo(rb.x), bfhi(ov.x) * bfhi(rb.x)); w.y = cvtpk(bflo(ov.y) * bflo(rb.y), bfhi(ov.y) * bfhi(rb.y));
                w.z = cvtpk(bflo(ov.z) * bflo(rb.z), bfhi(ov.z) * bfhi(rb.z)); w.w = cvtpk(bflo(ov.w) * bflo(rb.w), bfhi(ov.w) * bfhi(rb.w));
                if (MODE != 2) *(u32x4*)(yab + t * KAB + 512 + h * 512 + v8) = w; else asm volatile("" :: "v"(w)); } }
        __syncthreads();
    }
#undef GO_PRE
}
__device__ __forceinline__ void ph_gla_simple(const u16* Qb, const u16* Kb, const u16* Vb, const float* gkl, const float* wgk2, const float* bgk, float* Ob, LAS unsigned char* lds) {
    if (blockIdx.x >= 64) return;
    LAS float* sa = (LAS float*)lds; LAS float* sk = sa + 8 * 256; LAS float* sqv = sk + 8 * 256; LAS float* sv = sqv + 8 * 256; LAS float* part = sv + 8 * 64;
    int tid = threadIdx.x; asm volatile("" : "+v"(tid));
    const int blk = blockIdx.x, vs = blk & 7, h = (blk >> 3) & 3, b = blk >> 5, v = tid & 63, kg = tid >> 6, ch = tid & 255, ih = tid >> 8;
    float S[32];
#pragma unroll
    for (int i = 0; i < 32; ++i) S[i] = 0.f;
    float wk[16];
#pragma unroll
    for (int j = 0; j < 16; ++j) wk[j] = wgk2[j * 1024 + h * 256 + ch];
    const float bk = bgk[h * 256 + ch];
    for (int t0 = 0; t0 < SEQ; t0 += 8) {
        for (int ii = 0; ii < 4; ++ii) { const int i = ih * 4 + ii; const size_t t = (size_t)b * SEQ + t0 + i; float gk = bk;
#pragma unroll
            for (int j = 0; j < 16; ++j) gk += gkl[t * 16 + j] * wk[j];
            const float ls = fminf(gk, 0.f) - log1pf(expf(-fabsf(gk)));
            sa[i * 256 + ch] = expf(ls * (1.f / 16.f)); sk[i * 256 + ch] = bf2f(Kb[t * 1024 + h * 256 + ch]); sqv[i * 256 + ch] = bf2f(Qb[t * 1024 + h * 256 + ch]) * 0.0625f; }
        { const int i = tid >> 6, vv = tid & 63; sv[i * 64 + vv] = bf2f(Vb[((size_t)b * SEQ + t0 + i) * 2048 + h * 512 + vs * 64 + vv]); }
        __syncthreads();
        for (int i = 0; i < 8; ++i) { const float vv = sv[i * 64 + v]; float po = 0.f;
#pragma unroll
            for (int kk = 0; kk < 32; ++kk) { const int k = kg * 32 + kk; S[kk] = sa[i * 256 + k] * S[kk] + sk[i * 256 + k] * vv; po += sqv[i * 256 + k] * S[kk]; }
            part[(i * 8 + kg) * 64 + v] = po; }
        __syncthreads();
        { const int i = tid >> 6, vv = tid & 63; float o = 0.f;
#pragma unroll
            for (int q = 0; q < 8; ++q) o += part[(i * 8 + q) * 64 + vv];
            Ob[((size_t)b * SEQ + t0 + i) * 2048 + h * 512 + vs * 64 + vv] = o; }
    }
}
__device__ __forceinline__ void ph_gla_final(const float* Ob, const float* g, const u16* Rb, u16* yb, int gw, int NGW, int lane) {
    for (int item = gw; item < T * 4; item += NGW) { const int t = item >> 2, h = item & 3;
        const float* o = Ob + (size_t)t * 2048 + h * 512 + lane * 8; const f32x4 x0 = *(const f32x4*)o, x1 = *(const f32x4*)(o + 4);
        float ss = (x0[0] * x0[0] + x0[1] * x0[1]) + (x0[2] * x0[2] + x0[3] * x0[3]) + (x1[0] * x1[0] + x1[1] * x1[1]) + (x1[2] * x1[2] + x1[3] * x1[3]);
        ss = wave_sum(ss); const float r = rsqrtf(ss * (1.f / 512.f) + 1e-6f);
        const f32x4 g0 = *(const f32x4*)(g + lane * 8), g1 = *(const f32x4*)(g + lane * 8 + 4); const u32x4 rb = *(const u32x4*)(Rb + (size_t)t * 2048 + h * 512 + lane * 8);
        u32x4 w; w.x = cvtpk(x0[0] * r * g0[0] * bflo(rb.x), x0[1] * r * g0[1] * bfhi(rb.x)); w.y = cvtpk(x0[2] * r * g0[2] * bflo(rb.y), x0[3] * r * g0[3] * bfhi(rb.y));
        w.z = cvtpk(x1[0] * r * g1[0] * bflo(rb.z), x1[1] * r * g1[1] * bfhi(rb.z)); w.w = cvtpk(x1[2] * r * g1[2] * bflo(rb.w), x1[3] * r * g1[3] * bfhi(rb.w));
        *(u32x4*)(yb + (size_t)t * KAB + 512 + h * 512 + lane * 8) = w; }
}
constexpr int RT_LCNT = 131072, RT_GB = 131072 + 64, RT_REC = 131072 + 128;
__device__ __forceinline__ void ph_ln_router(const u16* __restrict__ pre, const float* __restrict__ g, const float* __restrict__ bb, const float* __restrict__ rw, const float* __restrict__ rb, u16* __restrict__ h1, u16* __restrict__ h1b,
                                             int* cnt, int* tok_of, int* tokinfo, LAS unsigned char* lds, int gw, int NGW, int lane, int wv) {
    LAS float* WL = (LAS float*)lds;
    int tid = WV_TID(wv); asm volatile("" : "+v"(tid));
    u32x4 nx[2][4];
    if (gw < T) { const int t1 = gw + NGW < T ? gw + NGW : gw;
#pragma unroll
        for (int jj = 0; jj < 4; ++jj) { nx[0][jj] = ((const u32x4*)(pre + (size_t)gw * D) + lane)[64 * jj]; nx[1][jj] = ((const u32x4*)(pre + (size_t)t1 * D) + lane)[64 * jj]; } }
    {
        f32x4 wst[16];
#pragma unroll
        for (int i = 0; i < 16; ++i) { const int idx = tid + 512 * i, c = idx >> 2, e4 = (idx & 3) * 4; wst[i] = *(const f32x4*)(rw + (size_t)c * 16 + e4); }
#pragma unroll
        for (int i = 0; i < 16; ++i) { const int idx = tid + 512 * i, c = idx >> 2, e4 = (idx & 3) * 4; const f32x4 w = wst[i];
            const int cp = ((c >> 2) & 1) * 1024 + (c >> 3) * 4 + (c & 3);
            WL[(e4 + 0) * 2048 + cp] = w[0]; WL[(e4 + 1) * 2048 + cp] = w[1]; WL[(e4 + 2) * 2048 + cp] = w[2]; WL[(e4 + 3) * 2048 + cp] = w[3]; } }
    if (tid < 16) ((LAS int*)(lds + RT_LCNT))[tid] = 0;
    __syncthreads();
    const float rbv = rb[lane & 15];
    int nrec = (tid >> 6) * 32;
    for (int t = gw; t < T; t += 2 * NGW) {
        const bool has1 = t + NGW < T; const int tt[2] = {t, has1 ? t + NGW : t};
        int lz = 0; asm volatile("" : "+v"(lz));
        u32x4 cur[2][4]; float rstd[2], mean[2];
#define LR_UNPK(q_, a_, b_) const f32x4 a_ = (f32x4){bflo((q_).x), bfhi((q_).x), bflo((q_).y), bfhi((q_).y)}, b_ = (f32x4){bflo((q_).z), bfhi((q_).z), bflo((q_).w), bfhi((q_).w)}
#pragma unroll
        for (int r = 0; r < 2; ++r) { float s = 0.f;
#pragma unroll
            for (int jj = 0; jj < 4; ++jj) { cur[r][jj] = nx[r][jj]; LR_UNPK(cur[r][jj], xa, xb);
                s += ((xa[0] + xa[1]) + (xa[2] + xa[3])) + ((xb[0] + xb[1]) + (xb[2] + xb[3])); }
            mean[r] = s; }
        { const int ta = t + 2 * NGW < T ? t + 2 * NGW : t, tb = t + 3 * NGW < T ? t + 3 * NGW : ta;
#pragma unroll
          for (int jj = 0; jj < 4; ++jj) { nx[0][jj] = ((const u32x4*)(pre + (size_t)ta * D) + lane)[64 * jj]; nx[1][jj] = ((const u32x4*)(pre + (size_t)tb * D) + lane)[64 * jj]; } }
#pragma unroll
        for (int r = 0; r < 2; ++r) { mean[r] = wave_sum(mean[r]) * (1.f / D); float s2 = 0.f;
#pragma unroll
            for (int jj = 0; jj < 4; ++jj) { LR_UNPK(cur[r][jj], xa, xb); const f32x4 da = xa - mean[r], db = xb - mean[r]; s2 += ((da[0] * da[0] + da[1] * da[1]) + (da[2] * da[2] + da[3] * da[3])) + ((db[0] * db[0] + db[1] * db[1]) + (db[2] * db[2] + db[3] * db[3])); }
            rstd[r] = rsqrtf(wave_sum(s2) * (1.f / D) + 1e-5f); }
        f32x2v lq[16];
#pragma unroll
        for (int e = 0; e < 16; ++e) lq[e] = (f32x2v){0.f, 0.f};
#pragma unroll
        for (int jj = 0; jj < 4; ++jj) { const int c = lane * 8 + 512 * jj;
            const f32x4 g0 = *(const f32x4*)(g + c + lz), g1 = *(const f32x4*)(g + c + lz + 4), b0 = *(const f32x4*)(bb + c + lz), b1 = *(const f32x4*)(bb + c + lz + 4);
            f32x4 y0[2], y1[2];
#pragma unroll
            for (int r = 0; r < 2; ++r) { LR_UNPK(cur[r][jj], xa, xb); y0[r] = (xa - mean[r]) * rstd[r] * g0 + b0; y1[r] = (xb - mean[r]) * rstd[r] * g1 + b1;
                { const size_t ro = (size_t)tt[r] * D + c;
                    u32x4 hk; hk.x = cvtpk(y0[r][0], y0[r][1]); hk.y = cvtpk(y0[r][2], y0[r][3]); hk.z = cvtpk(y1[r][0], y1[r][1]); hk.w = cvtpk(y1[r][2], y1[r][3]); *(u32x4*)(h1 + ro) = hk;
                    if (F8_MOE) { u32x2 w8; w8.x = cvt4_f8(y0[r][0] * F8_ACT, y0[r][1] * F8_ACT, y0[r][2] * F8_ACT, y0[r][3] * F8_ACT); w8.y = cvt4_f8(y1[r][0] * F8_ACT, y1[r][1] * F8_ACT, y1[r][2] * F8_ACT, y1[r][3] * F8_ACT); *(u32x2*)((unsigned char*)h1b + ro) = w8; }
                    else *(u32x4*)(h1b + ro) = hk; } }
            f32x2v yp[8];
#pragma unroll
            for (int k = 0; k < 4; ++k) { yp[k] = (f32x2v){y0[0][k], y0[1][k]}; yp[4 + k] = (f32x2v){y1[0][k], y1[1][k]}; }
#pragma unroll
            for (int e = 0; e < 16; ++e) { const f32x4 w4 = *(const LAS f32x4*)(WL + lz + e * 2048 + (lane + 64 * jj) * 4), w5 = *(const LAS f32x4*)(WL + lz + e * 2048 + 1024 + (lane + 64 * jj) * 4);
#pragma unroll
                for (int k = 0; k < 4; ++k) { lq[e] += yp[k] * w4[k]; lq[e] += yp[4 + k] * w5[k]; } } }
#pragma unroll
        for (int r = 0; r < 2; ++r) { if (r == 0 || has1) {
        float lg[16];
#pragma unroll
        for (int e = 0; e < 16; ++e) lg[e] = lq[e][r];
        float r8[8], r4[4], r2[2], r1;
        { const bool hi = lane & 1;
#pragma unroll
          for (int i = 0; i < 8; ++i) { const float keep = hi ? lg[2 * i + 1] : lg[2 * i], send = hi ? lg[2 * i] : lg[2 * i + 1]; r8[i] = keep + __shfl_xor(send, 1); } }
        { const bool hi = lane & 2;
#pragma unroll
          for (int i = 0; i < 4; ++i) { const float keep = hi ? r8[2 * i + 1] : r8[2 * i], send = hi ? r8[2 * i] : r8[2 * i + 1]; r4[i] = keep + __shfl_xor(send, 2); } }
        { const bool hi = lane & 4;
#pragma unroll
          for (int i = 0; i < 2; ++i) { const float keep = hi ? r4[2 * i + 1] : r4[2 * i], send = hi ? r4[2 * i] : r4[2 * i + 1]; r2[i] = keep + __shfl_xor(send, 4); } }
        { const bool hi = lane & 8; const float keep = hi ? r2[1] : r2[0], send = hi ? r2[0] : r2[1]; r1 = keep + __shfl_xor(send, 8); }
        r1 += __shfl_xor(r1, 16); r1 += __shfl_xor(r1, 32);
        const float mylogit = r1 + rbv;
        float mx = -INFINITY;
#pragma unroll
        for (int e = 0; e < 16; ++e) { lg[e] = __int_as_float(__builtin_amdgcn_readlane(__float_as_int(mylogit), e)); mx = fmaxf(mx, lg[e]); }
        float den = 0.f;
#pragma unroll
        for (int e = 0; e < 16; ++e) { lg[e] = expf(lg[e] - mx); den += lg[e]; }
        const float iden = 1.f / den;
        float best = -1.f; int i0 = 0, i1 = 1; float p0 = 0.f, p1 = 0.f;
#pragma unroll
        for (int gI = 0; gI < 4; ++gI) { float a = -1.f, b2 = -1.f; int ia = 0, ib = 0;
#pragma unroll
            for (int q = 0; q < 4; ++q) { const float pv = lg[gI * 4 + q] * iden; if (pv > a) { b2 = a; ib = ia; a = pv; ia = gI * 4 + q; } else if (pv > b2) { b2 = pv; ib = gI * 4 + q; } }
            const float gs = a + b2; if (gs > best) { best = gs; i0 = ia; i1 = ib; p0 = a; p1 = b2; } }
        if (lane == 0) { const float ws = 1.f / (p0 + p1);
            const int s0 = __hip_atomic_fetch_add((LAS int*)(lds + RT_LCNT) + i0, 1, __ATOMIC_RELAXED, __HIP_MEMORY_SCOPE_WORKGROUP), s1 = __hip_atomic_fetch_add((LAS int*)(lds + RT_LCNT) + i1, 1, __ATOMIC_RELAXED, __HIP_MEMORY_SCOPE_WORKGROUP);
            LAS int* rec = (LAS int*)(lds + RT_REC) + nrec * 8; rec[0] = tt[r]; rec[1] = i0; rec[2] = s0; rec[3] = __float_as_int(p0 * ws); rec[4] = i1; rec[5] = s1; rec[6] = __float_as_int(p1 * ws); }
        ++nrec; } }
    }
#undef LR_UNPK
    __syncthreads();
    if (tid < 16) { const int c = ((LAS int*)(lds + RT_LCNT))[tid]; int gb = 0; if (c > 0) gb = atomicAdd(cnt + 64 * tid, c); ((LAS int*)(lds + RT_GB))[tid] = gb; }
    __syncthreads();
    if (lane == 0) { const int wv = tid >> 6;
        for (int i = 0; i < nrec - wv * 32; ++i) { const LAS int* rec = (const LAS int*)(lds + RT_REC) + (wv * 32 + i) * 8; const int t = rec[0], i0 = rec[1], i1 = rec[4];
            const int s0 = ((LAS int*)(lds + RT_GB))[i0] + rec[2], s1 = ((LAS int*)(lds + RT_GB))[i1] + rec[5];
            tok_of[i0 * 8192 + s0] = t; tok_of[i1 * 8192 + s1] = t;
            int* ti = tokinfo + (size_t)t * 8; ti[0] = i0; ti[1] = s0; ti[2] = rec[3]; ti[3] = i1; ti[4] = s1; ti[5] = rec[6]; } }
    __syncthreads();
}
__device__ __forceinline__ void ph_gather(const u16* h1b, const int* cnt, const int* tok_of, u16* Xg, int gw, int NGW, int lane) {
    int pre[17], cn[16]; moe_prefix(cnt, lane, pre, cn);
    const int nrows = pre[16] * 256;
    for (int r = gw; r < nrows; r += NGW) { const int pr = r >> 8; int e = 0;
#pragma unroll
        for (int k = 1; k < 16; ++k) e += (pr >= pre[k]) ? 1 : 0;
        int pb = 0, ce = 0;
#pragma unroll
        for (int k = 0; k < 16; ++k) { if (e == k) { pb = pre[k]; ce = cn[k]; } }
        constexpr int RB = D * WEB, NJ = RB / 1024;
        const int slot = r - pb * 256; u32x4* dst = (u32x4*)((unsigned char*)Xg + (size_t)r * RB) + lane;
        if (slot < ce) { const int tok = tok_of[e * 8192 + slot]; const u32x4* src = (const u32x4*)((const unsigned char*)h1b + (size_t)tok * RB) + lane;
#pragma unroll
            for (int j = 0; j < NJ; ++j) dst[64 * j] = src[64 * j]; }
        else {
#pragma unroll
            for (int j = 0; j < NJ; ++j) dst[64 * j] = (u32x4){0u, 0u, 0u, 0u}; } }
}
__device__ __forceinline__ void ph_ln2_plain(const u16* h1, const u16* dn, const int* tokinfo, const int* cnt, const float* g, const float* bb, float* outf, u16* outh, u16* outb, int gw, int NGW, int lane) {
    int pre[17], cn[16]; moe_prefix(cnt, lane, pre, cn);
    for (int t = gw; t < T; t += NGW) {
        const int* ti = tokinfo + (size_t)t * 8; const int e0 = ti[0], e1 = ti[3]; int b0 = 0, b1 = 0;
#pragma unroll
        for (int k = 0; k < 16; ++k) { if (e0 == k) b0 = pre[k]; if (e1 == k) b1 = pre[k]; }
        const size_t r0 = (size_t)b0 * 256 + ti[1], r1 = (size_t)b1 * 256 + ti[4]; const float w0 = __int_as_float(ti[2]), w1 = __int_as_float(ti[5]);
        f32x4 v[4][2]; float s = 0.f;
#pragma unroll
        for (int j = 0; j < 4; ++j) { const int c = lane * 8 + 512 * j; const u32x4 hq_ = *(const u32x4*)(h1 + (size_t)t * D + c);
            const f32x4 h0 = (f32x4){bflo(hq_.x), bfhi(hq_.x), bflo(hq_.y), bfhi(hq_.y)}, h1v = (f32x4){bflo(hq_.z), bfhi(hq_.z), bflo(hq_.w), bfhi(hq_.w)};
            f32x4 ea0, ea1, eb0, eb1;
            if (DN_F8) { const u32x2 qa = *(const u32x2*)((const unsigned char*)dn + r0 * D + c), qb = *(const u32x2*)((const unsigned char*)dn + r1 * D + c);
                const f32x2v a0 = __builtin_amdgcn_cvt_pk_f32_fp8((int)qa.x, false), a1 = __builtin_amdgcn_cvt_pk_f32_fp8((int)qa.x, true), a2 = __builtin_amdgcn_cvt_pk_f32_fp8((int)qa.y, false), a3 = __builtin_amdgcn_cvt_pk_f32_fp8((int)qa.y, true);
                const f32x2v c0 = __builtin_amdgcn_cvt_pk_f32_fp8((int)qb.x, false), c1 = __builtin_amdgcn_cvt_pk_f32_fp8((int)qb.x, true), c2 = __builtin_amdgcn_cvt_pk_f32_fp8((int)qb.y, false), c3 = __builtin_amdgcn_cvt_pk_f32_fp8((int)qb.y, true);
                ea0 = (f32x4){a0[0], a0[1], a1[0], a1[1]} * (1.f / 16.f); ea1 = (f32x4){a2[0], a2[1], a3[0], a3[1]} * (1.f / 16.f); eb0 = (f32x4){c0[0], c0[1], c1[0], c1[1]} * (1.f / 16.f); eb1 = (f32x4){c2[0], c2[1], c3[0], c3[1]} * (1.f / 16.f); }
            else { const u32x4 qa = *(const u32x4*)(dn + r0 * D + c), qb = *(const u32x4*)(dn + r1 * D + c);
                ea0 = (f32x4){bflo(qa.x), bfhi(qa.x), bflo(qa.y), bfhi(qa.y)}; ea1 = (f32x4){bflo(qa.z), bfhi(qa.z), bflo(qa.w), bfhi(qa.w)}; eb0 = (f32x4){bflo(qb.x), bfhi(qb.x), bflo(qb.y), bfhi(qb.y)}; eb1 = (f32x4){bflo(qb.z), bfhi(qb.z), bflo(qb.w), bfhi(qb.w)}; }
            v[j][0] = h0 * DN_ALPHA + ea0 * w0 + eb0 * w1; v[j][1] = h1v * DN_ALPHA + ea1 * w0 + eb1 * w1;
            s += ((v[j][0][0] + v[j][0][1]) + (v[j][0][2] + v[j][0][3])) + ((v[j][1][0] + v[j][1][1]) + (v[j][1][2] + v[j][1][3])); }
        const float mean = wave_sum(s) * (1.f / D); float s2 = 0.f;
#pragma unroll
        for (int j = 0; j < 4; ++j)
#pragma unroll
            for (int q = 0; q < 2; ++q) { v[j][q] = v[j][q] - mean; s2 += (v[j][q][0] * v[j][q][0] + v[j][q][1] * v[j][q][1]) + (v[j][q][2] * v[j][q][2] + v[j][q][3] * v[j][q][3]); }
        const float rstd = rsqrtf(wave_sum(s2) * (1.f / D) + 1e-5f);
#pragma unroll
        for (int j = 0; j < 4; ++j) { const int c = lane * 8 + 512 * j;
            const f32x4 y0 = v[j][0] * rstd * *(const f32x4*)(g + c) + *(const f32x4*)(bb + c), y1 = v[j][1] * rstd * *(const f32x4*)(g + c + 4) + *(const f32x4*)(bb + c + 4);
            if (outf) { *(f32x4*)(outf + (size_t)t * D + c) = y0; *(f32x4*)(outf + (size_t)t * D + c + 4) = y1; }
            else { u32x4 hk; hk.x = cvtpk(y0[0], y0[1]); hk.y = cvtpk(y0[2], y0[3]); hk.z = cvtpk(y1[0], y1[1]); hk.w = cvtpk(y1[2], y1[3]); *(u32x4*)(outh + (size_t)t * D + c) = hk; }
            if (F8_IN) { u32x2 w8; w8.x = cvt4_f8(y0[0] * F8_ACT, y0[1] * F8_ACT, y0[2] * F8_ACT, y0[3] * F8_ACT); w8.y = cvt4_f8(y1[0] * F8_ACT, y1[1] * F8_ACT, y1[2] * F8_ACT, y1[3] * F8_ACT); *(u32x2*)((unsigned char*)outb + (size_t)t * D + c) = w8; }
            else { u32x4 pk; pk.x = cvtpk(y0[0], y0[1]); pk.y = cvtpk(y0[2], y0[3]); pk.z = cvtpk(y1[0], y1[1]); pk.w = cvtpk(y1[2], y1[3]); *(u32x4*)(outb + (size_t)t * D + c) = pk; } }
    }
}

__device__ __forceinline__ void ph_ln2(const u16* h1, const u16* dn, const int* tokinfo, const int* cnt, int cvp, const float* g, const float* bb, float* outf, u16* outh, u16* outb, int gw, int NGW, int lane) {
    if (!DN_F8) { ph_ln2_plain(h1, dn, tokinfo, cnt, g, bb, outf, outh, outb, gw, NGW, lane); return; }
    int pre[17], cn[16]; if (ONE_LAUNCH) moe_prefix_cv(cvp, lane, pre, cn); else moe_prefix(cnt, lane, pre, cn);
    if (gw >= T) return;
    u32x4 rh[4]; u32x2 ra[4], rb[4]; float nw0, nw1;
    u32x4 tiA; u32x2 tiB;
#define LN2_TI(tt) do { const int* ti_ = tokinfo + (size_t)(tt) * 8; tiA = *(const u32x4*)ti_; tiB = *(const u32x2*)(ti_ + 4); } while (0)
#define LN2_ISSUE(tt) do { const int e0 = (int)tiA.x, e1 = (int)tiA.w; int b0 = 0, b1 = 0; \
        _Pragma("unroll") for (int k = 0; k < 16; ++k) { if (e0 == k) b0 = pre[k]; if (e1 == k) b1 = pre[k]; } \
        const size_t r0 = (size_t)b0 * 256 + (int)tiA.y, r1 = (size_t)b1 * 256 + (int)tiB.x; nw0 = __int_as_float((int)tiA.z); nw1 = __int_as_float((int)tiB.y); \
        _Pragma("unroll") for (int j = 0; j < 4; ++j) { const int c = lane * 8 + 512 * j; rh[j] = *(const u32x4*)(h1 + (size_t)(tt) * D + c); \
            ra[j] = *(const u32x2*)((const unsigned char*)dn + r0 * D + c); rb[j] = *(const u32x2*)((const unsigned char*)dn + r1 * D + c); } } while (0)
    LN2_TI(gw); LN2_ISSUE(gw);
    { const int t1 = gw + NGW < T ? gw + NGW : gw; LN2_TI(t1); }
    for (int t = gw; t < T; t += NGW) {
        const float w0 = nw0, w1 = nw1;
        f32x4 v[4][2]; float s = 0.f;
#pragma unroll
        for (int j = 0; j < 4; ++j) { const u32x4 hq_ = rh[j]; const u32x2 qa = ra[j], qb = rb[j];
            const f32x4 h0 = (f32x4){bflo(hq_.x), bfhi(hq_.x), bflo(hq_.y), bfhi(hq_.y)}, h1v = (f32x4){bflo(hq_.z), bfhi(hq_.z), bflo(hq_.w), bfhi(hq_.w)};
            const f32x2v a0 = __builtin_amdgcn_cvt_pk_f32_fp8((int)qa.x, false), a1 = __builtin_amdgcn_cvt_pk_f32_fp8((int)qa.x, true), a2 = __builtin_amdgcn_cvt_pk_f32_fp8((int)qa.y, false), a3 = __builtin_amdgcn_cvt_pk_f32_fp8((int)qa.y, true);
            const f32x2v c0 = __builtin_amdgcn_cvt_pk_f32_fp8((int)qb.x, false), c1 = __builtin_amdgcn_cvt_pk_f32_fp8((int)qb.x, true), c2 = __builtin_amdgcn_cvt_pk_f32_fp8((int)qb.y, false), c3 = __builtin_amdgcn_cvt_pk_f32_fp8((int)qb.y, true);
            const f32x4 ea0 = (f32x4){a0[0], a0[1], a1[0], a1[1]} * (1.f / 16.f), ea1 = (f32x4){a2[0], a2[1], a3[0], a3[1]} * (1.f / 16.f), eb0 = (f32x4){c0[0], c0[1], c1[0], c1[1]} * (1.f / 16.f), eb1 = (f32x4){c2[0], c2[1], c3[0], c3[1]} * (1.f / 16.f);
            v[j][0] = h0 * DN_ALPHA + ea0 * w0 + eb0 * w1; v[j][1] = h1v * DN_ALPHA + ea1 * w0 + eb1 * w1;
            s += ((v[j][0][0] + v[j][0][1]) + (v[j][0][2] + v[j][0][3])) + ((v[j][1][0] + v[j][1][1]) + (v[j][1][2] + v[j][1][3])); }
        { const int tn = t + NGW < T ? t + NGW : t, tnn = tn + NGW < T ? tn + NGW : tn; LN2_ISSUE(tn); LN2_TI(tnn); }
        const float mean = wave_sum(s) * (1.f / D); float s2 = 0.f;
#pragma unroll
        for (int j = 0; j < 4; ++j)
#pragma unroll
            for (int q = 0; q < 2; ++q) { v[j][q] = v[j][q] - mean; s2 += (v[j][q][0] * v[j][q][0] + v[j][q][1] * v[j][q][1]) + (v[j][q][2] * v[j][q][2] + v[j][q][3] * v[j][q][3]); }
        const float rstd = rsqrtf(wave_sum(s2) * (1.f / D) + 1e-5f);
#pragma unroll
        for (int j = 0; j < 4; ++j) { const int c = lane * 8 + 512 * j;
            const f32x4 y0 = v[j][0] * rstd * *(const f32x4*)(g + c) + *(const f32x4*)(bb + c), y1 = v[j][1] * rstd * *(const f32x4*)(g + c + 4) + *(const f32x4*)(bb + c + 4);
            if (outf) { *(f32x4*)(outf + (size_t)t * D + c) = y0; *(f32x4*)(outf + (size_t)t * D + c + 4) = y1; }
            else { u32x4 hk; hk.x = cvtpk(y0[0], y0[1]); hk.y = cvtpk(y0[2], y0[3]); hk.z = cvtpk(y1[0], y1[1]); hk.w = cvtpk(y1[2], y1[3]); *(u32x4*)(outh + (size_t)t * D + c) = hk; }
            if (F8_IN) { u32x2 w8; w8.x = cvt4_f8(y0[0] * F8_ACT, y0[1] * F8_ACT, y0[2] * F8_ACT, y0[3] * F8_ACT); w8.y = cvt4_f8(y1[0] * F8_ACT, y1[1] * F8_ACT, y1[2] * F8_ACT, y1[3] * F8_ACT); *(u32x2*)((unsigned char*)outb + (size_t)t * D + c) = w8; }
            else { u32x4 pk; pk.x = cvtpk(y0[0], y0[1]); pk.y = cvtpk(y0[2], y0[3]); pk.z = cvtpk(y1[0], y1[1]); pk.w = cvtpk(y1[2], y1[3]); *(u32x4*)(outb + (size_t)t * D + c) = pk; } }
    }
#undef LN2_TI
#undef LN2_ISSUE
}

__global__ void __launch_bounds__(512, 2) fwd(Args a) {
    extern __shared__ __attribute__((aligned(16))) unsigned char lds_raw[];
    LAS unsigned char* lds = (LAS unsigned char*)lds_raw;
    volatile LAS unsigned* MISC = (volatile LAS unsigned*)(lds + MISC_OFF);
    const int tid = threadIdx.x;
    const int wv_s = __builtin_amdgcn_readfirstlane(tid >> 6);
    const int G = gridDim.x, bx = blockIdx.x, NGW = G * 8, NGT = G * 512;
#define PH_IDS() int tid_ = WV_TID(wv_s); asm volatile("" : "+v"(tid_)); const int lane = tid_ & 63, wave = __builtin_amdgcn_readfirstlane(tid_ >> 6), gw = bx * 8 + wave, gt = bx * 512 + tid_; (void)gw; (void)gt; (void)lane; (void)wave; size_t wz_ = 0; asm volatile("" : "+s"(wz_)); unsigned char* wsl = a.ws + wz_
    unsigned char* ws = a.ws; unsigned* ctl = (unsigned*)(ws + WS_CTL);
    if (tid < 64) MISC[tid] = 0u;
    __syncthreads();
    const bool multi = ONE_LAUNCH || (a.ph_hi - a.ph_lo) > 1;
    XcdBarrier bar; bar.bar = ctl + CW_BAR; bar.x = 0; bar.st = nullptr;
    if (multi) bar = xcd_barrier_post(ctl + CW_BAR, MISC + 8);
    const int lo = a.ph_lo, hi = a.ph_hi;
#ifndef PHMASK
#define PHMASK 0xFFFFFFFFu
#endif
#if ONE_LAUNCH
#define IN(k) true
#else
#define IN(k) (lo <= (k) && (k) < hi)
#endif
#define EN(j) ((PHMASK >> (j)) & 1u)
#ifndef REPMASK
#define REPMASK 0u
#endif
#ifndef REPN
#define REPN 1
#endif
#define REP(j) for (int rp_ = 0; rp_ <= (int)(REPN * ((REPMASK >> (j)) & 1u)); ++rp_)
#define REPBAR() do { if (rp_ > 0 || false) {} } while (0)
#ifndef SEAMX
#define SEAMX 1
#endif
#define SEAM(k) do { if (IN(k) && IN((k) + 1)) { for (int sx_ = 0; sx_ < SEAMX; ++sx_) xcd_barrier(bar, wv_s); } } while (0)
#define W16(off) ((u16*)(wsl + (off)))
#define WF(off) ((float*)(wsl + (off)))
#define WI(off) ((int*)(wsl + (off)))
    REP(11) if (rp_ == 0 || (xcd_barrier(bar, wv_s), true)) if (EN(11) && IN(0)) { PH_IDS(); ph_prologue(a, lds, gw, NGW, wave, lane); }
    SEAM(0);
    int cvp = 0;
    for (int l = 0; l < DEPTH; ++l) {
        const int pb = 1 + NPH_LAYER * l;
        REP(0) if (rp_ == 0 || (xcd_barrier(bar, wv_s), true)) if (EN(0) && IN(pb + 0)) { PH_IDS(); ProbInProj P; P.A = W16(P_HB); P.Bt = W16(WS_WIN + l * SZ_WIN); P.G = G; P.c = bx; P.ws = wsl; P.gkl = WF(P_GKL); P.tab = WF(WS_TAB);
            const int nbg = (BG_WGS > 0 && G >= 4 * BG_WGS) ? BG_WGS : 0;
            if (BG_WGS > 0 && nbg == 0) { ph_bgconv(a, lds, l == 0 ? BGP_A : BGP_D, l == 0 ? BGP_B : BGP_E, gw, NGW, wave, lane); __syncthreads(); }
            if (nbg > 0) P.G = G - nbg;
            if (nbg > 0 && bx >= G - nbg) ph_bgconv(a, lds, l == 0 ? BGP_A : BGP_D, l == 0 ? BGP_B : BGP_E, (bx - (G - nbg)) * 8 + wave, nbg * 8, wave, lane);
            else pg8::gemm_run(lds, P, wv_s); }
        SEAM(pb + 0);
        REP(1) if (rp_ == 0 || (xcd_barrier(bar, wv_s), true)) if (EN(1) && IN(pb + 1)) { PH_IDS();
#if ATTN_SIMPLE
            ph_attn_simple(W16(P_QA), W16(P_KA), W16(P_VA), W16(P_OA), WF(P_LSE), lds, gw, NGW, wave, lane);
#else
            for (int r2_ = 0; r2_ <= (int)((REPMASK >> 14) & 1u); ++r2_) ph_attn(W16(P_QA), W16(P_KA), W16(P_VA), W16(P_OA), WF(P_LSE), lds, bx, G, wv_s);
#endif
#if !GLA_SIMPLE
            for (int r3_ = 0; r3_ <= (int)((REPMASK >> 15) & 1u); ++r3_) ph_gla_prep(W16(P_QB), W16(P_KB), W16(P_VB), WF(P_GKL), a.w_gk2 + (size_t)l * 16 * 1024, a.b_gk + (size_t)l * 1024, W16(P_QT), W16(P_KDT), W16(P_VT), W16(P_ATT), WF(P_DEC), lds, bx, G, wv_s);
#endif
        }
        SEAM(pb + 1);
        REP(2) if (rp_ == 0 || (xcd_barrier(bar, wv_s), true)) if (EN(2) && IN(pb + 2)) { PH_IDS();
#if GLA_SIMPLE
            ph_gla_simple(W16(P_QB), W16(P_KB), W16(P_VB), WF(P_GKL), a.w_gk2 + (size_t)l * 16 * 1024, a.b_gk + (size_t)l * 1024, WF(P_OB), lds);
            for (int r3_ = 0; r3_ <= (int)((REPMASK >> 13) & 1u); ++r3_) ph_ya(W16(P_OA), WF(P_LSE), W16(P_YAB), gt, NGT); }
#else
#ifdef PROBE_SCAN_NOSTORE
            ph_gla_scan<false>(W16(P_KDT), W16(P_VT), WF(P_DEC), W16(P_SN), lds, bx, G, wv_s);
#endif
            YaPre yap; ya_request(W16(P_OA), WF(P_LSE), gt, NGT, yap);
            for (int r2_ = 0; r2_ <= (int)((REPMASK >> 12) & 1u); ++r2_) ph_gla_scan(W16(P_KDT), W16(P_VT), WF(P_DEC), W16(P_SN), lds, bx, G, wv_s);
            ya_finish(yap, W16(P_YAB), gt, NGT);
            for (int r3_ = 0; r3_ <= (int)((REPMASK >> 13) & 1u); ++r3_) ph_ya(W16(P_OA), WF(P_LSE), W16(P_YAB), gt + 4 * NGT, NGT); }
#endif
        SEAM(pb + 2);
        REP(3) if (rp_ == 0 || (xcd_barrier(bar, wv_s), true)) if (EN(3) && IN(pb + 3)) { PH_IDS();
#if GLA_SIMPLE
            ph_gla_final(WF(P_OB), a.g_gla + (size_t)l * 512, W16(P_RB), W16(P_YAB), gw, NGW, lane);
#else
#ifdef PROBE_OUT_MODE
            ph_gla_out<PROBE_OUT_MODE>(W16(P_SN), W16(P_QT), W16(P_VT), W16(P_ATT), a.g_gla + (size_t)l * 512, W16(P_RB), W16(P_YAB), lds, bx, G, wv_s);
#endif
            ph_gla_out(W16(P_SN), W16(P_QT), W16(P_VT), W16(P_ATT), a.g_gla + (size_t)l * 512, W16(P_RB), W16(P_YAB), lds, bx, G, wv_s);
#endif
        }
        SEAM(pb + 3);
        REP(4) if (rp_ == 0 || (xcd_barrier(bar, wv_s), true)) if (EN(4) && IN(pb + 4)) { PH_IDS(); ProbMerge P; P.yab = W16(P_YAB); P.PabT = W16(WS_PAB + l * SZ_PAB); P.Ga = W16(P_GA); P.Gb = W16(P_GB); P.mrg = W16(P_MRG); P.G = G; P.c = bx;
            pg8::gemm_run(lds, P, wv_s); }
        SEAM(pb + 4);
        REP(5) if (rp_ == 0 || (xcd_barrier(bar, wv_s), true)) if (EN(5) && IN(pb + 5)) { PH_IDS(); ProbWo P; P.A = W16(P_MRG); P.Bt = W16(WS_WO + l * SZ_WO); P.hres = l == 0 ? (const void*)a.x : (const void*)W16(P_HC); P.hres_bf16 = l != 0; P.pre1 = W16(P_PRE1); P.G = G; P.c = bx;
            pg8::gemm_run(lds, P, wv_s); }
        SEAM(pb + 5);
        REP(6) if (rp_ == 0 || (xcd_barrier(bar, wv_s), true)) if (EN(6) && IN(pb + 6)) { PH_IDS(); ph_ln_router(W16(P_PRE1), a.ln1_g + (size_t)l * D, a.ln1_b + (size_t)l * D, a.router_w, a.router_b, W16(P_H1), W16(P_H1B), WI(WS_CTL) + CW_CNT + 2048 * l + (((REPMASK >> 6) & 1u) && rp_ == 0 ? 1024 : 0), WI(P_TOK) + 131072 * l, WI(P_TI), lds, gw, NGW, lane, wv_s); }
        SEAM(pb + 6);
        REP(8) if (rp_ == 0 || (xcd_barrier(bar, wv_s), true)) if (EN(8) && IN(pb + 8)) { PH_IDS(); ProbGateUp P; P.Xg = W16(P_H1B); P.tok = WI(P_TOK) + 131072 * l; P.pcnt = (unsigned*)WI(WS_CTL) + CW_PANEL + 5120 * l; P.Wgu = W16(WS_WGU + l * SZ_WGU); P.act = W16(P_ACT); P.G = G; P.c = bx;
            const int cvg = moe_cnt_load(WI(WS_CTL) + CW_CNT + 2048 * l, lane);
            int nbg = 0;
            if (BG_WGS > 0 && G >= 4 * BG_WGS) { const int need = (((moe_npanels(cvg) * 11 + 3) >> 2) + 7) & ~7; nbg = G - need;        nbg = nbg < BG_GUMIN ? BG_GUMIN : (nbg > BG_WGS ? BG_WGS : nbg); }
            if (BG_WGS > 0 && nbg == 0) { ph_bgconv(a, lds, l == 0 ? BGP_B : BGP_E, l == 0 ? BGP_C : BGP_F, gw, NGW, wave, lane); __syncthreads(); }
            if (nbg > 0) P.G = G - nbg;
            if (nbg > 0 && bx >= G - nbg) ph_bgconv(a, lds, l == 0 ? BGP_B : BGP_E, l == 0 ? BGP_C : BGP_F, (bx - (G - nbg)) * 8 + wave, nbg * 8, wave, lane);
            else { int cn[16]; moe_prefix_cv(cvg, lane, P.pre, cn); pg8::gemm_run(lds, P, wv_s); } }
        if (ONE_LAUNCH && !MOE_CHAIN) { unsigned char* wsl = a.ws; cvp = moe_cnt_load(WI(WS_CTL) + CW_CNT + 2048 * l, (int)lane_id()); }
        if (!MOE_CHAIN) SEAM(pb + 8);
        REP(9) if (rp_ == 0 || (xcd_barrier(bar, wv_s), true)) if (EN(9) && IN(pb + 9)) { PH_IDS(); ProbDown P; P.pcnt = (unsigned*)WI(WS_CTL) + CW_PANEL + 5120 * l; P.tmo = (unsigned*)WI(WS_CTL) + CW_TMO; P.act = W16(P_ACT); P.Wd = W16(WS_WD + l * SZ_WD); P.dn = W16(P_DN); P.G = G; P.c = bx;
            const bool hostd = BG_WGS > 0 && l == 0 && G >= 4 * BG_WGS;
            if (BG_WGS > 0 && l == 0 && !hostd) { ph_bgconv(a, lds, BGP_C, BGP_D, gw, NGW, wave, lane); __syncthreads(); }
            const int cvd = (ONE_LAUNCH && !MOE_CHAIN) ? cvp : moe_cnt_load(WI(WS_CTL) + CW_CNT + 2048 * l, lane);
            int nbd = BG_WGS;
            if (hostd) { const int need = (((moe_npanels(cvd) * 8 + 2) / 3) + 7) & ~7; nbd = G - need; nbd = nbd < BG_GUMIN ? BG_GUMIN : (nbd > BG_WGS ? BG_WGS : nbd); }
            if (hostd) P.G = G - nbd;
            if (hostd && bx >= G - nbd) ph_bgconv(a, lds, BGP_C, BGP_D, (bx - (G - nbd)) * 8 + wave, nbd * 8, wave, lane);
            else { int cn[16]; moe_prefix_cv(cvd, lane, P.pre, cn); pg8::gemm_run(lds, P, wv_s); } }
        if (ONE_LAUNCH) { unsigned char* wsl = a.ws; cvp = moe_cnt_load(WI(WS_CTL) + CW_CNT + 2048 * l, (int)lane_id()); }
        SEAM(pb + 9);
        REP(10) if (rp_ == 0 || (xcd_barrier(bar, wv_s), true)) if (EN(10) && IN(pb + 10)) { PH_IDS(); ph_ln2(W16(P_H1), W16(P_DN), WI(P_TI), WI(WS_CTL) + CW_CNT + 2048 * l, cvp, a.ln2_g + (size_t)l * D, a.ln2_b + (size_t)l * D, l == DEPTH - 1 ? a.out : (float*)nullptr, W16(P_HC), W16(P_HB), gw, NGW, lane); }
        SEAM(pb + 10);
    }
#undef IN
#undef SEAM
}

#ifndef ONE_LAUNCH
#define ONE_LAUNCH 1
#endif
extern "C" void kernel_launch(void* const* d_in, const int* in_sizes, int n_in, void* d_out, int out_size, void* d_ws, size_t ws_size, hipStream_t stream) {
    static int grid = 0;
    if (grid == 0) {
        if (n_in != 18 || ws_size < P_END) { fprintf(stderr, "kernel_launch: n_in %d ws %zu (need %zu): nothing launched\n", n_in, ws_size, (size_t)P_END); grid = -1; return; }
        int dev = 0, cus = 0;
        if (hipGetDevice(&dev) != hipSuccess || hipDeviceGetAttribute(&cus, hipDeviceAttributeMultiprocessorCount, dev) != hipSuccess) { grid = -1; return; }
        if (hipFuncSetAttribute((const void*)fwd, hipFuncAttributeMaxDynamicSharedMemorySize, LDS_BYTES) != hipSuccess) { fprintf(stderr, "kernel_launch: hipFuncSetAttribute failed\n"); grid = -1; return; }
        int per_cu = 0;
        if (hipOccupancyMaxActiveBlocksPerMultiprocessor(&per_cu, (const void*)fwd, 512, LDS_BYTES) != hipSuccess || per_cu < 1) fprintf(stderr, "kernel_launch: occupancy query says %d blocks per CU\n", per_cu);
        (void)hipGetLastError();
        grid = cus;
    }
    if (grid < 0) return;
    (void)hipMemsetAsync((char*)d_ws + WS_CTL, 0, CTL_ZERO_BYTES, stream);
    Args a{};
    a.x = (const float*)d_in[0]; a.pos = (const int*)d_in[1]; a.w_in = (const float*)d_in[2]; a.w_gk2 = (const float*)d_in[3]; a.b_gk = (const float*)d_in[4]; a.g_gla = (const float*)d_in[5];
    a.p_a = (const float*)d_in[6]; a.p_b = (const float*)d_in[7]; a.w_o = (const float*)d_in[8]; a.ln1_g = (const float*)d_in[9]; a.ln1_b = (const float*)d_in[10]; a.router_w = (const float*)d_in[11];
    a.router_b = (const float*)d_in[12]; a.w_gate = (const float*)d_in[13]; a.w_up = (const float*)d_in[14]; a.w_down = (const float*)d_in[15]; a.ln2_g = (const float*)d_in[16]; a.ln2_b = (const float*)d_in[17];
    a.out = (float*)d_out; a.ws = (unsigned char*)d_ws;
#if ONE_LAUNCH
#ifdef EXTRA_PROLOGUE
    a.ph_lo = 0; a.ph_hi = 1; hipLaunchKernelGGL(fwd, dim3(grid), dim3(512), LDS_BYTES, stream, a);
#endif
    a.ph_lo = 0; a.ph_hi = NPH; hipLaunchKernelGGL(fwd, dim3(grid), dim3(512), LDS_BYTES, stream, a);
#else
    for (int ph = 0; ph < NPH; ++ph) { a.ph_lo = ph; a.ph_hi = ph + 1; hipLaunchKernelGGL(fwd, dim3(grid), dim3(512), LDS_BYTES, stream, a); }
#endif
}
```
